# Optimizing an MI355X kernel written in HIP

```python
import jax, jax.numpy as jnp
from jax import lax
import numpy as np

D_MODEL = 4096
BATCH = 4
SEQ = 4096
DEPTH = 4

CHUNK = 64
N_META = 16
Q_BLOCK = 128
MLA_HEADS = D_MODEL // 256
NOPE_DIM = 128
ROPE_DIM = 64
QK_DIM = NOPE_DIM + ROPE_DIM
V_DIM = 128
MLA_WIDTH = MLA_HEADS * V_DIM
Q_LORA = D_MODEL // 4
KV_LORA = D_MODEL // 8
POOL_WINDOWS = (2, 4, 8, 16)
POOL_GROUPS = 4
POOL_WIDTH = D_MODEL // 2
POOL_GROUP_DIM = POOL_WIDTH // POOL_GROUPS
ROPE_THETA = 10000.0
NORM_EPS = 1e-6
IN_SPLITS = (Q_LORA, KV_LORA, ROPE_DIM, POOL_WIDTH, MLA_WIDTH, POOL_WIDTH, D_MODEL, D_MODEL)
IN_WIDTH = Q_LORA + KV_LORA + ROPE_DIM + POOL_WIDTH + MLA_WIDTH + POOL_WIDTH + 2 * D_MODEL

kernel_name = "hybrid_mla_pool_gated_merge_trunk"


def _rms(x, g):
    xf = x.astype(jnp.float32)
    y = xf * lax.rsqrt(jnp.mean(xf * xf, axis=-1, keepdims=True) + NORM_EPS)
    return (y * g.astype(jnp.float32)).astype(x.dtype)


def _rope_tables(length):
    pos = jnp.arange(length, dtype=jnp.float32)
    inv = 1.0 / (ROPE_THETA ** (jnp.arange(0, ROPE_DIM, 2, dtype=jnp.float32) / ROPE_DIM))
    ang = pos[:, None] * inv[None, :]
    return jnp.cos(ang)[:, None, :], jnp.sin(ang)[:, None, :]


def _apply_rope(x, cos, sin):
    xf = x.astype(jnp.float32)
    x1, x2 = jnp.split(xf, 2, axis=-1)
    return jnp.concatenate([x1 * cos - x2 * sin, x2 * cos + x1 * sin], axis=-1).astype(x.dtype)


def _attend_block(q_blk, cid_q, k, v, cid_k):
    s = jnp.einsum('bqhd,bkhd->bhqk', q_blk, k, preferred_element_type=jnp.float32) * (QK_DIM ** -0.5)
    mask = cid_k[None, :] <= cid_q[:, None]
    s = jnp.where(mask[None, None], s, jnp.float32(-1e30))
    p = jax.nn.softmax(s, axis=-1).astype(v.dtype)
    return jnp.einsum('bhqk,bkhd->bqhd', p, v)


def _mla(c_q_raw, c_kv_raw, k_rope_raw, q_lora_g, kv_lora_g, w_uq, w_ukv, q_head_g, k_head_g, cos, sin, cid):
    b, length, _ = c_q_raw.shape
    c_q = _rms(c_q_raw, q_lora_g)
    c_kv = _rms(c_kv_raw, kv_lora_g)
    q = (c_q @ w_uq).reshape(b, length, MLA_HEADS, QK_DIM)
    kv = (c_kv @ w_ukv).reshape(b, length, MLA_HEADS, NOPE_DIM + V_DIM)
    k_nope, v = kv[..., :NOPE_DIM], kv[..., NOPE_DIM:]
    k_rope = jnp.broadcast_to(k_rope_raw[:, :, None, :], (b, length, MLA_HEADS, ROPE_DIM))
    k = jnp.concatenate([k_nope, k_rope], axis=-1)
    q = _rms(q, q_head_g)
    k = _rms(k, k_head_g)
    q = jnp.concatenate([q[..., :NOPE_DIM], _apply_rope(q[..., NOPE_DIM:], cos, sin)], axis=-1)
    k = jnp.concatenate([k[..., :NOPE_DIM], _apply_rope(k[..., NOPE_DIM:], cos, sin)], axis=-1)
    out_meta = _attend_block(q[:, :N_META], cid[:N_META], k, v, cid)
    n_blk = (length - N_META) // Q_BLOCK
    q_blocks = jnp.moveaxis(q[:, N_META:].reshape(b, n_blk, Q_BLOCK, MLA_HEADS, QK_DIM), 1, 0)
    cid_blocks = cid[N_META:].reshape(n_blk, Q_BLOCK)
    out_blocks = lax.map(lambda a: _attend_block(a[0], a[1], k, v, cid), (q_blocks, cid_blocks))
    out_real = jnp.moveaxis(out_blocks, 0, 1).reshape(b, length - N_META, MLA_HEADS, V_DIM)
    out = jnp.concatenate([out_meta, out_real], axis=1)
    return out.reshape(b, length, MLA_WIDTH)


def _pool_mixer(u, w_pool, pool_scale):
    b, length, _ = u.shape
    uf = u.astype(jnp.float32)
    cs = jnp.cumsum(uf, axis=1)
    pos1 = jnp.arange(length, dtype=jnp.float32) + 1.0
    pooled = []
    for g, w in enumerate(POOL_WINDOWS):
        c = cs[..., g * POOL_GROUP_DIM:(g + 1) * POOL_GROUP_DIM]
        prev = jnp.pad(c, ((0, 0), (w, 0), (0, 0)))[:, :length]
        count = jnp.minimum(pos1, jnp.float32(w))[None, :, None]
        pooled.append((c - prev) / count)
    pooled = jnp.concatenate(pooled, axis=-1)
    diff = (pooled - uf).astype(u.dtype).reshape(b, length, POOL_GROUPS, POOL_GROUP_DIM)
    mixed = jnp.einsum('blgc,gcd->blgd', diff, w_pool).reshape(b, length, POOL_WIDTH)
    return mixed * pool_scale


def setup_inputs(seed: int = 0) -> dict:
    key = jax.random.key(seed)
    ks = jax.random.split(key, 20)
    f32 = jnp.float32

    def w(k, shape, fan_in):
        return jax.random.normal(k, shape, f32) * (fan_in ** -0.5)

    def gain(k, shape):
        return 1.0 + 0.05 * jax.random.normal(k, shape, f32)

    return {
        "x": jax.random.normal(ks[0], (BATCH, SEQ, D_MODEL), f32),
        "meta_tokens": jax.random.normal(ks[1], (N_META, D_MODEL), f32),
        "norm_g": gain(ks[2], (DEPTH, D_MODEL)),
        "w_in": w(ks[3], (DEPTH, D_MODEL, IN_WIDTH), D_MODEL),
        "q_lora_g": gain(ks[4], (DEPTH, Q_LORA)),
        "kv_lora_g": gain(ks[5], (DEPTH, KV_LORA)),
        "w_uq": w(ks[6], (DEPTH, Q_LORA, MLA_HEADS * QK_DIM), Q_LORA),
        "w_ukv": w(ks[7], (DEPTH, KV_LORA, MLA_HEADS * (NOPE_DIM + V_DIM)), KV_LORA),
        "q_head_g": gain(ks[8], (DEPTH, QK_DIM)),
        "k_head_g": gain(ks[9], (DEPTH, QK_DIM)),
        "w_pool": w(ks[10], (DEPTH, POOL_GROUPS, POOL_GROUP_DIM, POOL_GROUP_DIM), POOL_GROUP_DIM),
        "pool_scale": 1.0 + 0.1 * jax.random.normal(ks[11], (DEPTH, POOL_WIDTH), f32),
        "w_branch_a": w(ks[12], (DEPTH, MLA_WIDTH, D_MODEL), MLA_WIDTH),
        "w_branch_b": w(ks[13], (DEPTH, POOL_WIDTH, D_MODEL), POOL_WIDTH),
        "w_out": w(ks[14], (DEPTH, D_MODEL, D_MODEL), D_MODEL),
    }


def reference(x, meta_tokens, norm_g, w_in, q_lora_g, kv_lora_g, w_uq, w_ukv, q_head_g, k_head_g,
              w_pool, pool_scale, w_branch_a, w_branch_b, w_out):
    b, seq, _ = x.shape
    length = N_META + seq
    h = jnp.concatenate([jnp.broadcast_to(meta_tokens[None].astype(x.dtype), (b, N_META, D_MODEL)), x], axis=1)
    cid = jnp.concatenate([jnp.zeros((N_META,), jnp.int32),
                           jnp.arange(seq, dtype=jnp.int32) // CHUNK + 1])
    cos, sin = _rope_tables(length)
    bounds = []
    acc = 0
    for s in IN_SPLITS[:-1]:
        acc += s
        bounds.append(acc)
    for l in range(DEPTH):
        hn = _rms(h, norm_g[l])
        proj = hn @ w_in[l]
        c_q_raw, c_kv_raw, k_rope_raw, pool_in, gate_a, gate_b, merge_a, merge_b = jnp.split(proj, bounds, axis=-1)
        attn = _mla(c_q_raw, c_kv_raw, k_rope_raw, q_lora_g[l], kv_lora_g[l], w_uq[l], w_ukv[l],
                    q_head_g[l], k_head_g[l], cos, sin, cid)
        br_a = (attn * jax.nn.silu(gate_a)) @ w_branch_a[l]
        pooled = _pool_mixer(pool_in, w_pool[l], pool_scale[l])
        br_b = (pooled * jax.nn.silu(gate_b)) @ w_branch_b[l]
        merged = jax.nn.sigmoid(merge_a) * br_a + jax.nn.sigmoid(merge_b) * br_b
        h = h + merged @ w_out[l]
    return h[:, N_META:]
```

```cpp
#include <hip/hip_runtime.h>
#include <cstdio>
#include <cstdint>

#ifndef MK_PER_PHASE
#define MK_PER_PHASE 0
#endif

namespace pg8 {
#define PG8_LAS __attribute__((address_space(3)))
typedef unsigned short bf16_t;
typedef short bf16x8 __attribute__((ext_vector_type(8)));
typedef float f32x4 __attribute__((ext_vector_type(4)));
typedef unsigned u32x4 __attribute__((ext_vector_type(4)));
constexpr int BM = 256, BK = 64, HALF = 128, HTB = HALF * BK * 2  , STAGE_BYTES = 8 * HTB, NXCD = 8, WGM = 8;

__host__ __device__ __forceinline__ int lds_byte(int r, int c) { const int st = (r >> 4) * 2 + (c >> 5), rr = r & 15, cc = c & 31, ob = rr * 64 + cc * 2; return st * 1024 + (ob ^ (((ob >> 9) & 1) << 5)); }
__host__ __device__ __forceinline__ void stage_rc(int b, int& R, int& C) { const int st = b / 1024, sb = b % 1024, swz = sb ^ (((sb >> 9) & 1) << 5); R = (st >> 1) * 16 + swz / 64; C = (st & 1) * 32 + (swz % 64) / 2; }
__host__ __device__ __forceinline__ int perm32(int rho) { const int n = rho >> 4, i = rho & 15; return 8 * (i >> 2) + 4 * n + (i & 3); }

struct Unit { int pm, pn; unsigned aoff; };
struct Gemm { const bf16_t* A; const bf16_t* Bt; int lda, ldb, K; };

struct StaticOrder {
    int nM, nN, nwg, G, c;
    __host__ __device__ void init(int M, int N, int G_, int c_) { nM = M / BM; nN = N / BM; nwg = nM * nN; G = G_; c = c_; }
    __host__ __device__ bool next(int i, Unit& u) const {
        const long L = (long)i * G + c; if (L >= nwg) return false;
        int wgid = (int)L; { const int q = nwg / NXCD, r = nwg % NXCD, xcd = wgid % NXCD, off = wgid / NXCD; wgid = (xcd < r ? xcd * (q + 1) : r * (q + 1) + (xcd - r) * q) + off; }
        const int nig = WGM * nN, gid = wgid / nig, fm = gid * WGM, gsz = (nM - fm) < WGM ? (nM - fm) : WGM;
        u.pm = fm + ((wgid % nig) % gsz); u.pn = (wgid % nig) / gsz; u.aoff = 0u; return true;
    }
    __device__ __forceinline__ void a_ready(const Unit&) const {}
    __device__ __forceinline__ void done(const Unit&) const {}
};
__device__ __forceinline__ unsigned cvt_pk_bf16(float lo, float hi) { unsigned r; asm volatile("v_cvt_pk_bf16_f32 %0, %1, %2" : "=v"(r) : "v"(lo), "v"(hi)); return r; }
typedef unsigned u32x2 __attribute__((ext_vector_type(2)));
__device__ __forceinline__ float bflo(unsigned u) { return __uint_as_float(u << 16); }
__device__ __forceinline__ float bfhi(unsigned u) { return __uint_as_float(u & 0xffff0000u); }
__device__ __forceinline__ float sigmoidf_(float x) { return __builtin_amdgcn_rcpf(1.0f + __builtin_amdgcn_exp2f(-1.4426950408889634f * x)); }

constexpr int MROWS_ = 16448, LSEQ_ = 4112;

struct EpiProj {
    static constexpr bool PERM = true, AFTER_DRAIN = false;
    bf16_t* O; int ldc; int silu_lo, silu_hi, sig_lo, sig_hi;
    __device__ __forceinline__ void operator()(const f32x4 (&acc)[2][2][4][2], const Unit& u, int wr, int wc, int fr, int fq) const {
        const int row0 = u.pm * BM + wr * 64 + fr; const int col0 = u.pn * BM + wc * 32 + 8 * fq;
        const int act = (u.pn >= silu_lo && u.pn < silu_hi) ? 1 : ((u.pn >= sig_lo && u.pn < sig_hi) ? 2 : 0);
#pragma unroll
        for (int ai = 0; ai < 2; ++ai)
#pragma unroll
            for (int m = 0; m < 4; ++m) { bf16_t* rowp = O + (size_t)(row0 + ai * HALF + m * 16) * ldc + col0;
#pragma unroll
                for (int bj = 0; bj < 2; ++bj) { f32x4 v0 = acc[ai][bj][m][0], v1 = acc[ai][bj][m][1];
                    if (act) {
#pragma unroll
                        for (int j = 0; j < 4; ++j) { const float s0 = sigmoidf_(v0[j]), s1 = sigmoidf_(v1[j]); v0[j] = (act == 1) ? v0[j] * s0 : s0; v1[j] = (act == 1) ? v1[j] * s1 : s1; } }
                    u32x4 w; w.x = cvt_pk_bf16(v0[0], v0[1]); w.y = cvt_pk_bf16(v0[2], v0[3]); w.z = cvt_pk_bf16(v1[0], v1[1]); w.w = cvt_pk_bf16(v1[2], v1[3]);
                    *(u32x4*)(rowp + bj * HALF) = w; } }
    }
};
struct EpiKV {
    static constexpr bool PERM = true, AFTER_DRAIN = false;
    bf16_t* KRAW; bf16_t* VA; int lp;
    __device__ __forceinline__ void operator()(const f32x4 (&acc)[2][2][4][2], const Unit& u, int wr, int wc, int fr, int fq) const {
        const int row0 = u.pm * BM + wr * 64 + fr; const int h = u.pn; const int c0 = wc * 32 + 8 * fq;
#pragma unroll
        for (int ai = 0; ai < 2; ++ai)
#pragma unroll
            for (int m = 0; m < 4; ++m) { const int row = row0 + ai * HALF + m * 16;
                { const f32x4 v0 = acc[ai][0][m][0], v1 = acc[ai][0][m][1]; u32x4 w; w.x = cvt_pk_bf16(v0[0], v0[1]); w.y = cvt_pk_bf16(v0[2], v0[3]); w.z = cvt_pk_bf16(v1[0], v1[1]); w.w = cvt_pk_bf16(v1[2], v1[3]);
                  *(u32x4*)(KRAW + (size_t)row * 2048 + h * 128 + c0) = w; }
                if (row < MROWS_) { const int b = row / LSEQ_, pos = row - b * LSEQ_, pp = pos < 16 ? pos : pos + 48;
                  const f32x4 v0 = acc[ai][1][m][0], v1 = acc[ai][1][m][1]; u32x4 w; w.x = cvt_pk_bf16(v0[0], v0[1]); w.y = cvt_pk_bf16(v0[2], v0[3]); w.z = cvt_pk_bf16(v1[0], v1[1]); w.w = cvt_pk_bf16(v1[2], v1[3]);
                  *(u32x4*)(VA + ((size_t)(b * 16 + h) * lp + pp) * 128 + c0) = w; } }
    }
};
struct EpiPool {
    static constexpr bool PERM = true, AFTER_DRAIN = false;
    bf16_t* XAB; const bf16_t* GB; int ldg; const float* scale;
    __device__ __forceinline__ void operator()(const f32x4 (&acc)[2][2][4][2], const Unit& u, int wr, int wc, int fr, int fq) const {
        const int row0 = u.pm * BM + wr * 64 + fr; const int col0 = u.pn * BM + wc * 32 + 8 * fq;
        f32x4 sc[2][2];
#pragma unroll
        for (int bj = 0; bj < 2; ++bj)
#pragma unroll
            for (int n = 0; n < 2; ++n) sc[bj][n] = *(const f32x4*)(scale + col0 + bj * HALF + 4 * n);
#pragma unroll
        for (int ai = 0; ai < 2; ++ai)
#pragma unroll
            for (int m = 0; m < 4; ++m) { const size_t row = (size_t)(row0 + ai * HALF + m * 16);
#pragma unroll
                for (int bj = 0; bj < 2; ++bj) { const u32x4 g = *(const u32x4*)(GB + row * ldg + col0 + bj * HALF);
                    const f32x4 v0 = acc[ai][bj][m][0] * sc[bj][0], v1 = acc[ai][bj][m][1] * sc[bj][1];
                    u32x4 w; w.x = cvt_pk_bf16(v0[0] * bflo(g.x), v0[1] * bfhi(g.x)); w.y = cvt_pk_bf16(v0[2] * bflo(g.y), v0[3] * bfhi(g.y));
                    w.z = cvt_pk_bf16(v1[0] * bflo(g.z), v1[1] * bfhi(g.z)); w.w = cvt_pk_bf16(v1[2] * bflo(g.w), v1[3] * bfhi(g.w));
                    *(u32x4*)(XAB + row * 4096 + col0 + bj * HALF) = w; } }
    }
};
struct EpiT1 {
    static constexpr bool PERM = false, AFTER_DRAIN = false;
    float* T1; const bf16_t* MA; int ldg;
    __device__ __forceinline__ void operator()(const f32x4 (&acc)[2][2][4][2], const Unit& u, int wr, int wc, int fr, int fq) const {
        const int row0 = u.pm * BM + wr * 64 + fr, col0 = u.pn * BM + wc * 32 + 4 * fq;
#pragma unroll
        for (int ai = 0; ai < 2; ++ai)
#pragma unroll
            for (int m = 0; m < 4; ++m) { const size_t row = (size_t)(row0 + ai * HALF + m * 16);
#pragma unroll
                for (int bj = 0; bj < 2; ++bj)
#pragma unroll
                    for (int n = 0; n < 2; ++n) { const int c = col0 + bj * HALF + n * 16; const u32x2 g = *(const u32x2*)(MA + row * ldg + c);
                        f32x4 v = acc[ai][bj][m][n]; v[0] *= bflo(g.x); v[1] *= bfhi(g.x); v[2] *= bflo(g.y); v[3] *= bfhi(g.y);
                        *(f32x4*)(T1 + row * 4096 + c) = v; } }
    }
};
struct EpiMerge {
    static constexpr bool PERM = false, AFTER_DRAIN = false;
    const float* T1; const bf16_t* MB; int ldg; bf16_t* MG;
    __device__ __forceinline__ void operator()(const f32x4 (&acc)[2][2][4][2], const Unit& u, int wr, int wc, int fr, int fq) const {
        const int row0 = u.pm * BM + wr * 64 + fr, col0 = u.pn * BM + wc * 32 + 4 * fq;
#pragma unroll
        for (int ai = 0; ai < 2; ++ai)
#pragma unroll
            for (int m = 0; m < 4; ++m) { const size_t row = (size_t)(row0 + ai * HALF + m * 16);
#pragma unroll
                for (int bj = 0; bj < 2; ++bj)
#pragma unroll
                    for (int n = 0; n < 2; ++n) { const int c = col0 + bj * HALF + n * 16; const u32x2 g = *(const u32x2*)(MB + row * ldg + c); const f32x4 t = *(const f32x4*)(T1 + row * 4096 + c);
                        const f32x4 a = acc[ai][bj][m][n]; u32x2 w; w.x = cvt_pk_bf16(t[0] + a[0] * bflo(g.x), t[1] + a[1] * bfhi(g.x)); w.y = cvt_pk_bf16(t[2] + a[2] * bflo(g.y), t[3] + a[3] * bfhi(g.y));
                        *(u32x2*)(MG + row * 4096 + c) = w; } }
    }
};
struct EpiRes {
    static constexpr bool PERM = false, AFTER_DRAIN = false;
    float* H; float* OUT;
    __device__ __forceinline__ void operator()(const f32x4 (&acc)[2][2][4][2], const Unit& u, int wr, int wc, int fr, int fq) const {
        const int row0 = u.pm * BM + wr * 64 + fr, col0 = u.pn * BM + wc * 32 + 4 * fq;
#pragma unroll
        for (int ai = 0; ai < 2; ++ai)
#pragma unroll
            for (int m = 0; m < 4; ++m) { const int row = row0 + ai * HALF + m * 16; float* hp = H + (size_t)row * 4096 + col0;
                if (OUT) { if (row < MROWS_) { const int b = row / LSEQ_, pos = row - b * LSEQ_; if (pos >= 16) { float* op = OUT + ((size_t)b * 4096 + (pos - 16)) * 4096 + col0;
#pragma unroll
                    for (int bj = 0; bj < 2; ++bj)
#pragma unroll
                        for (int n = 0; n < 2; ++n) { const int c = bj * HALF + n * 16; *(f32x4*)(op + c) = *(const f32x4*)(hp + c) + acc[ai][bj][m][n]; } } } }
                else {
#pragma unroll
                    for (int bj = 0; bj < 2; ++bj)
#pragma unroll
                        for (int n = 0; n < 2; ++n) { const int c = bj * HALF + n * 16; *(f32x4*)(hp + c) = *(const f32x4*)(hp + c) + acc[ai][bj][m][n]; } } }
    }
};
struct PoolOrder : StaticOrder {
    __host__ __device__ bool next(int i, Unit& u) const { if (!StaticOrder::next(i, u)) return false; u.aoff = (unsigned)(u.pn >> 1) * 1024u; return true; }
};

template <class Epi, class Sched, bool ALIGN_EPI = false, bool SP2 = false>
__device__ __forceinline__ void gemm_phase(PG8_LAS unsigned char* lds, const Gemm g, const Sched& S, const Epi& E) {
    int tid = threadIdx.x; asm volatile("" : "+v"(tid));
    const int wid = __builtin_amdgcn_readfirstlane(tid >> 6), lane = tid & 63, wr = wid >> 2, wc = wid & 3, fr = lane & 15, fq = lane >> 4;
    const int K = g.K, nt = K / BK;
    unsigned voffA[2], voffB[2];
#pragma unroll
    for (int i = 0; i < 2; ++i) { int R, C; stage_rc(tid * 16 + i * 8192, R, C); const int Rb = Epi::PERM ? ((R & ~31) + perm32(R & 31)) : R;
        voffA[i] = (unsigned)(R * g.lda + C) * 2u; voffB[i] = (unsigned)(Rb * g.ldb + C) * 2u; }
    const size_t kstep = (size_t)(BK * 2);
    const size_t hstepA = (size_t)HALF * g.lda * 2, hstepB = (size_t)HALF * g.ldb * 2;
    const size_t tstepA = 2 * hstepA, tstepB = 2 * hstepB;
    const unsigned ldsw = (unsigned)wid * 1024u;
    const int aoff = lds_byte(wr * 64 + fr, fq * 8), boff = lds_byte(wc * 32 + fr, fq * 8);
#define PG8_SA(b, h) (((b) * 2 + (h)) * HTB)
#define PG8_SB(b, h) ((4 + (b) * 2 + (h)) * HTB)
#define PG8_STAGE(bufoff, gbase, voff) do { _Pragma("unroll") for (int _i = 0; _i < 2; ++_i) \
        __builtin_amdgcn_global_load_lds((const unsigned*)((const char*)(gbase) + (voff)[_i]), (PG8_LAS unsigned*)(lds + (bufoff) + ldsw + _i * 8192), 16, 0, 0); } while (0)
#define PG8_LDA(dst, b, h) do { _Pragma("unroll") for (int m = 0; m < 4; ++m) _Pragma("unroll") for (int k = 0; k < 2; ++k) dst[m][k] = *(const PG8_LAS bf16x8*)(lds + PG8_SA(b, h) + aoff + m * 2048 + k * 1024); } while (0)
#define PG8_LDB(dst, b, h) do { _Pragma("unroll") for (int n = 0; n < 2; ++n) _Pragma("unroll") for (int k = 0; k < 2; ++k) dst[n][k] = *(const PG8_LAS bf16x8*)(lds + PG8_SB(b, h) + boff + n * 2048 + k * 1024); } while (0)
#define PG8_MMA(ai, bj, At, Bt) do { __builtin_amdgcn_s_setprio(1); _Pragma("unroll") for (int m = 0; m < 4; ++m) _Pragma("unroll") for (int n = 0; n < 2; ++n) _Pragma("unroll") for (int k = 0; k < 2; ++k) \
        acc[ai][bj][m][n] = __builtin_amdgcn_mfma_f32_16x16x32_bf16(Bt[n][k], At[m][k], acc[ai][bj][m][n], 0, 0, 0); __builtin_amdgcn_s_setprio(0); } while (0)
#define PG8_WAIT_V(n) asm volatile("s_waitcnt vmcnt(" #n ")" ::: "memory")
#define PG8_WAIT_L(n) asm volatile("s_waitcnt lgkmcnt(" #n ")" ::: "memory")
#define PG8_BAR __builtin_amdgcn_s_barrier()
#define PG8_SCHED __builtin_amdgcn_sched_barrier(0)
    Unit cur, nxt; int ui = 0;
    if (!S.next(0, cur)) return;
    f32x4 acc[2][2][4][2];
#pragma unroll
    for (int a = 0; a < 2; ++a)
#pragma unroll
        for (int b = 0; b < 2; ++b)
#pragma unroll
            for (int m = 0; m < 4; ++m)
#pragma unroll
                for (int n = 0; n < 2; ++n) acc[a][b][m][n] = (f32x4){0.f, 0.f, 0.f, 0.f};
    bf16x8 At[4][2], B0[2][2], B1[2][2];
    const char* cA = (const char*)g.A + (size_t)cur.pm * tstepA + cur.aoff; const char* cB = (const char*)g.Bt + (size_t)cur.pn * tstepB;
    S.a_ready(cur);
    if constexpr (SP2) {
        PG8_STAGE(PG8_SB(0, 0), cB, voffB); PG8_STAGE(PG8_SB(0, 1), cB + hstepB, voffB); PG8_STAGE(PG8_SA(0, 0), cA, voffA); PG8_STAGE(PG8_SA(0, 1), cA + hstepA, voffA);
        if (wr == 1) PG8_BAR;
        PG8_WAIT_V(2); PG8_BAR;
        PG8_STAGE(PG8_SB(1, 0), cB + kstep, voffB); PG8_STAGE(PG8_SA(1, 0), cA + kstep, voffA); PG8_STAGE(PG8_SB(1, 1), cB + hstepB + kstep, voffB);
        PG8_WAIT_V(6); PG8_BAR;
    } else {
        PG8_STAGE(PG8_SB(0, 0), cB, voffB); PG8_STAGE(PG8_SA(0, 0), cA, voffA); PG8_STAGE(PG8_SB(0, 1), cB + hstepB, voffB); PG8_STAGE(PG8_SA(0, 1), cA + hstepA, voffA);
        if (wr == 1) PG8_BAR;
        PG8_WAIT_V(4); PG8_BAR;
        PG8_STAGE(PG8_SB(1, 0), cB + kstep, voffB); PG8_STAGE(PG8_SA(1, 0), cA + kstep, voffA); PG8_STAGE(PG8_SB(1, 1), cB + hstepB + kstep, voffB);
        PG8_WAIT_V(6); PG8_BAR;
    }
    for (;;) {
        const bool has_next = S.next(ui + 1, nxt);
        const char* nA = has_next ? (const char*)g.A + (size_t)nxt.pm * tstepA + nxt.aoff : cA; const char* nB = has_next ? (const char*)g.Bt + (size_t)nxt.pn * tstepB : cB;
        for (int t = 0; t < nt; t += 2) {
            const bool last = (t == nt - 2);
            const char* a1 = cA + (size_t)(t + 1) * kstep;
            const char* a2 = last ? nA : cA + (size_t)(t + 2) * kstep; const char* b2 = last ? nB : cB + (size_t)(t + 2) * kstep;
            const char* a3 = a2 + kstep; const char* b3 = b2 + kstep;
            if (last && has_next) S.a_ready(nxt);
            if constexpr (SP2) {
            PG8_LDB(B0, 0, 0); PG8_LDB(B1, 0, 1); PG8_SCHED; PG8_LDA(At, 0, 0); PG8_STAGE(PG8_SA(1, 1), a1 + hstepA, voffA);
            PG8_WAIT_V(8); PG8_WAIT_L(0); PG8_BAR; PG8_MMA(0, 0, At, B0); PG8_MMA(0, 1, At, B1); PG8_BAR; PG8_SCHED;
            PG8_LDA(At, 0, 1); PG8_STAGE(PG8_SB(0, 0), b2, voffB); PG8_STAGE(PG8_SB(0, 1), b2 + hstepB, voffB); PG8_STAGE(PG8_SA(0, 0), a2, voffA);
            PG8_WAIT_V(8); PG8_WAIT_L(0); PG8_BAR; PG8_MMA(1, 0, At, B0); PG8_MMA(1, 1, At, B1); PG8_BAR; PG8_SCHED;
            PG8_LDB(B0, 1, 0); PG8_LDB(B1, 1, 1); PG8_SCHED; PG8_LDA(At, 1, 0); PG8_STAGE(PG8_SA(0, 1), a2 + hstepA, voffA);
            PG8_WAIT_V(8); PG8_WAIT_L(0); PG8_BAR; PG8_MMA(0, 0, At, B0); PG8_MMA(0, 1, At, B1); PG8_BAR; PG8_SCHED;
            PG8_LDA(At, 1, 1); PG8_STAGE(PG8_SB(1, 0), b3, voffB); PG8_STAGE(PG8_SB(1, 1), b3 + hstepB, voffB); PG8_STAGE(PG8_SA(1, 0), a3, voffA);
            PG8_WAIT_V(8); PG8_WAIT_L(0); PG8_BAR; PG8_MMA(1, 0, At, B0); PG8_MMA(1, 1, At, B1); PG8_BAR; PG8_SCHED;
            } else {
            PG8_LDB(B0, 0, 0); PG8_SCHED; PG8_LDA(At, 0, 0); PG8_STAGE(PG8_SA(1, 1), a1 + hstepA, voffA);
            PG8_WAIT_L(8); PG8_BAR; PG8_WAIT_L(0); PG8_MMA(0, 0, At, B0); PG8_BAR; PG8_SCHED;
            PG8_LDB(B1, 0, 1); PG8_STAGE(PG8_SB(0, 0), b2, voffB);
            PG8_BAR; PG8_WAIT_L(0); PG8_MMA(0, 1, At, B1); PG8_BAR;
            PG8_LDA(At, 0, 1); PG8_STAGE(PG8_SA(0, 0), a2, voffA);
            PG8_BAR; PG8_WAIT_L(0); PG8_MMA(1, 0, At, B0); PG8_BAR; PG8_SCHED;
            PG8_STAGE(PG8_SB(0, 1), b2 + hstepB, voffB);
            PG8_WAIT_V(6); PG8_BAR; PG8_MMA(1, 1, At, B1); PG8_BAR;
            PG8_LDB(B0, 1, 0); PG8_SCHED; PG8_LDA(At, 1, 0); PG8_STAGE(PG8_SA(0, 1), a2 + hstepA, voffA);
            PG8_WAIT_L(8); PG8_BAR; PG8_WAIT_L(0); PG8_MMA(0, 0, At, B0); PG8_BAR; PG8_SCHED;
            PG8_LDB(B1, 1, 1); PG8_STAGE(PG8_SB(1, 0), b3, voffB);
            PG8_BAR; PG8_WAIT_L(0); PG8_MMA(0, 1, At, B1); PG8_BAR;
            PG8_LDA(At, 1, 1); PG8_STAGE(PG8_SA(1, 0), a3, voffA);
            PG8_BAR; PG8_WAIT_L(0); PG8_MMA(1, 0, At, B0); PG8_BAR; PG8_SCHED;
            PG8_STAGE(PG8_SB(1, 1), b3 + hstepB, voffB);
            PG8_WAIT_V(6); PG8_BAR; PG8_MMA(1, 1, At, B1); PG8_BAR;
            }
        }
        if constexpr (ALIGN_EPI) { if (wr == 0) PG8_BAR; }
        if constexpr (!Epi::AFTER_DRAIN) { E(acc, cur, wr, wc, fr, fq); S.done(cur); }
        if (!has_next) break;
#pragma unroll
        for (int a = 0; a < 2; ++a)
#pragma unroll
            for (int b = 0; b < 2; ++b)
#pragma unroll
                for (int m = 0; m < 4; ++m)
#pragma unroll
                    for (int n = 0; n < 2; ++n) acc[a][b][m][n] = (f32x4){0.f, 0.f, 0.f, 0.f};
        cur = nxt; cA = nA; cB = nB; ++ui;
        if constexpr (ALIGN_EPI) { if (wr == 1) PG8_BAR; }
    }
    PG8_WAIT_V(0);
    if constexpr (!ALIGN_EPI) { if (wr == 0) PG8_BAR; }
    PG8_BAR;
    if constexpr (Epi::AFTER_DRAIN) { E.fused(acc, cur, wr, wc, fr, fq, lds, wid, lane); S.done(cur); }
#undef PG8_SA
#undef PG8_SB
#undef PG8_STAGE
#undef PG8_LDA
#undef PG8_LDB
#undef PG8_MMA
#undef PG8_WAIT_V
#undef PG8_WAIT_L
#undef PG8_BAR
#undef PG8_SCHED
}
}
#ifndef PG8_SP2
#define PG8_SP2 true
#endif
#ifndef PG8_ALIGN
#define PG8_ALIGN true
#endif

constexpr int NWAVES = 8;
constexpr int D_MODEL = 4096, BATCH = 4, SEQ = 4096, DEPTH = 4, N_META = 16, LSEQ = N_META + SEQ  , MROWS = BATCH * LSEQ  , MP = 16640  ;
constexpr int HEADS = 16, NOPE = 128, ROPE = 64, QKD = 192, VD = 128, MLAW = 2048, QLORA = 1024, KVLORA = 512, POOLW = 2048;
constexpr int IN_WIDTH = 15936, NIN = 16128;
constexpr int PC_CQ = 0, PC_CKV = 1024, PC_U = 1536, PC_GA = 3584, PC_GB = 5632, PC_MA = 7680, PC_MB = 11776, PC_KR = 15872;
constexpr int LP = 4160;
constexpr float NORM_EPS = 1e-6f;
static_assert(MROWS == pg8::MROWS_ && LSEQ == pg8::LSEQ_, "shape constants");

constexpr size_t al256(size_t x) { return (x + 255) / 256 * 256; }
constexpr size_t WS_CTL = 0, CTL_ZERO_BYTES = 1u << 20;
constexpr size_t WS_TAB = CTL_ZERO_BYTES;
constexpr size_t WS_W = WS_TAB + al256((size_t)LSEQ * 32 * 8);
constexpr size_t WL_IN = 0, WL_UQ = WL_IN + (size_t)NIN * 4096 * 2, WL_UKV = WL_UQ + (size_t)3072 * 1024 * 2, WL_POOL = WL_UKV + (size_t)4096 * 512 * 2,
                 WL_AB = WL_POOL + (size_t)2048 * 512 * 2, WL_OUT = WL_AB + (size_t)4096 * 4096 * 2, WL_SIZE = WL_OUT + (size_t)4096 * 4096 * 2;
constexpr size_t WS_H = WS_W + DEPTH * WL_SIZE;
constexpr size_t WS_HN = WS_H + (size_t)MP * 4096 * 4;
constexpr size_t WS_PROJ = WS_HN + (size_t)MP * 4096 * 2;
constexpr size_t WS_CQN = WS_PROJ + (size_t)MP * NIN * 2;
constexpr size_t WS_CKVN = WS_CQN + (size_t)MP * 1024 * 2;
constexpr size_t WS_DIFF = WS_CKVN + (size_t)MP * 512 * 2;
constexpr size_t WS_QRAW = WS_DIFF + (size_t)MP * 2048 * 2;
constexpr size_t WS_KRAW = WS_QRAW + (size_t)MP * 3072 * 2;
constexpr size_t WS_QA = WS_KRAW + (size_t)MP * 2048 * 2;
constexpr size_t WS_KA = WS_QA + (size_t)64 * LP * 192 * 2;
constexpr size_t WS_VA = WS_KA + (size_t)64 * LP * 192 * 2;
constexpr size_t WS_XAB = WS_VA + (size_t)64 * LP * 128 * 2;
constexpr size_t WS_T1 = WS_XAB + (size_t)MP * 4096 * 2;
constexpr size_t WS_MG = WS_T1 + (size_t)MP * 4096 * 4;
constexpr size_t WS_END = WS_MG + (size_t)MP * 4096 * 2 + 65536;
constexpr int CW_TMO = 0, CW_BAR = 4096;

constexpr int RING_OFF = 0, RING_BYTES = 131072, LDSCTL_OFF = RING_BYTES, MISC_OFF = LDSCTL_OFF + 320, LDS_BYTES = 147456;

#define GAS __attribute__((address_space(1)))
#define LAS __attribute__((address_space(3)))
typedef unsigned short bf16;
typedef unsigned v4u __attribute__((ext_vector_type(4)));
typedef unsigned v2u __attribute__((ext_vector_type(2)));
typedef float f32x4 __attribute__((ext_vector_type(4)));
typedef short bf16x8 __attribute__((ext_vector_type(8)));
typedef short s16x4 __attribute__((ext_vector_type(4)));
typedef float f32x16 __attribute__((ext_vector_type(16)));
#define LDS_WAIT() asm volatile("s_waitcnt lgkmcnt(0)" ::: "memory")
#define VM_WAIT() asm volatile("s_waitcnt vmcnt(0)" ::: "memory")
#define WG_BAR() do { asm volatile("s_waitcnt lgkmcnt(0)" ::: "memory"); __builtin_amdgcn_s_barrier(); asm volatile("" ::: "memory"); } while (0)
__device__ __forceinline__ unsigned cvtpk(float lo, float hi) { unsigned r; asm volatile("v_cvt_pk_bf16_f32 %0, %1, %2" : "=v"(r) : "v"(lo), "v"(hi)); return r; }
__device__ __forceinline__ float bflo(unsigned u) { return __uint_as_float(u << 16); }
__device__ __forceinline__ float bfhi(unsigned u) { return __uint_as_float(u & 0xffff0000u); }
__device__ __forceinline__ float wave_sum(float v) {
#pragma unroll
    for (int o = 1; o < 64; o <<= 1) v += __shfl_xor(v, o);
    return v;
}

#define XB_TMO      128
#define XB_XCNT(j)  (256  + 64 * (j))
#define XB_XSUB(j)  (1280 + 64 * (j))
#define XB_XGEN(j)  (2304 + 64 * (j))
#define XB_TOP      3328
#define XB_TOPGEN   3392
#define XCD_BAR_WORDS 3456
#define XB_SPIN_CAP (1u << 18)
__device__ __forceinline__ unsigned xb_ld(unsigned* p)              { return __hip_atomic_load(p, __ATOMIC_RELAXED, __HIP_MEMORY_SCOPE_AGENT); }
__device__ __forceinline__ unsigned xb_add(unsigned* p, unsigned v) { return __hip_atomic_fetch_add(p, v, __ATOMIC_RELAXED, __HIP_MEMORY_SCOPE_AGENT); }
__device__ __forceinline__ unsigned xb_xcc_id() { return (unsigned)__builtin_amdgcn_s_getreg((3 << 11) | 20) & 0xFu; }
#define XB_SPIN(cond, bar) do { unsigned _sp = 0; while (cond) { __builtin_amdgcn_s_sleep(1); \
    if ((++_sp & 255u) == 0u) { if (xb_ld(&(bar)[XB_TMO])) break; if (_sp > XB_SPIN_CAP) { atomicAdd(&(bar)[XB_TMO], 1u); break; } } } } while (0)
struct XcdBarrier { unsigned* bar; unsigned x; volatile LAS unsigned* st; };
__device__ __forceinline__ XcdBarrier xcd_barrier_post(unsigned* bar, volatile LAS unsigned* st) {
    XcdBarrier b; b.bar = bar; b.x = xb_xcc_id(); b.st = st;
    if (threadIdx.x == 0) (void)xb_add(&bar[XB_XCNT(b.x)], 1u);
    return b;
}
__device__ __forceinline__ void xcd_barrier_complete(unsigned* bar, unsigned x, unsigned& nloc, unsigned& nx) {
    const unsigned G = gridDim.x * gridDim.y * gridDim.z;
    unsigned sum, cnt, mine, sp = 0u;
    for (;;) {
        sum = 0u; cnt = 0u; mine = 0u;
#pragma unroll
        for (unsigned j = 0; j < 16; ++j) { const unsigned c = xb_ld(&bar[XB_XCNT(j)]); sum += c; cnt += (c > 0u) ? 1u : 0u; mine = (j == x) ? c : mine; }
        if (sum == G) break;
        __builtin_amdgcn_s_sleep(1);
        if ((++sp & 255u) == 0u) { if (xb_ld(&bar[XB_TMO])) break; if (sp > XB_SPIN_CAP) { atomicAdd(&bar[XB_TMO], 1u); break; } }
    }
    nloc = mine > 0u ? mine : 1u; nx = cnt > 0u ? cnt : 1u;
}
__device__ __forceinline__ void xcd_barrier(const XcdBarrier& b) {
    asm volatile("s_waitcnt vmcnt(0)" ::: "memory");
    __syncthreads();
    if (threadIdx.x == 0) {
        unsigned* bar = b.bar;
        __builtin_amdgcn_s_waitcnt(0);
        unsigned nloc = b.st[0], nx = b.st[1];
        if (nloc == 0u) { xcd_barrier_complete(bar, b.x, nloc, nx); b.st[0] = nloc; b.st[1] = nx; }
        const unsigned old = xb_add(&bar[XB_XSUB(b.x)], 1u);
        const unsigned gen = old / nloc;
        if (old + 1u == (gen + 1u) * nloc) {
            __builtin_amdgcn_fence(__ATOMIC_RELEASE, "agent");
            asm volatile("s_waitcnt vmcnt(0)" ::: "memory");
            const unsigned og = xb_add(&bar[XB_TOP], 1u);
            const unsigned tg = og / nx;
            if (og + 1u == (tg + 1u) * nx) xb_add(&bar[XB_TOPGEN], 1u);
            else XB_SPIN(xb_ld(&bar[XB_TOPGEN]) == tg, bar);
            __builtin_amdgcn_fence(__ATOMIC_ACQUIRE, "agent");
            xb_add(&bar[XB_XGEN(b.x)], 1u);
            asm volatile("s_waitcnt vmcnt(0)" ::: "memory");
        } else {
            XB_SPIN(xb_ld(&bar[XB_XGEN(b.x)]) == gen, bar);
            __builtin_amdgcn_fence(__ATOMIC_ACQUIRE, "agent");
            asm volatile("s_waitcnt vmcnt(0)" ::: "memory");
        }
    }
    __syncthreads();
}

struct Frame {
    LAS unsigned char* lds;
    int tid, lane, wave, vcu, G;
    unsigned char* ws;
    const float* in[15];
    float* out;
};
enum { I_X = 0, I_META, I_NORMG, I_WIN, I_QLG, I_KVLG, I_WUQ, I_WUKV, I_QHG, I_KHG, I_WPOOL, I_PSCALE, I_WA, I_WB, I_WOUT };

__device__ __forceinline__ void tr_item(const float* W, int ldw, int k0, int nsrc0, bf16* WT, int ldt, int ndst0, int kdst0, LAS float* scr, int lane) {
#pragma unroll 8
    for (int i = 0; i < 32; ++i) { const int kk = 2 * i + (lane >> 5); scr[kk * 33 + (lane & 31)] = W[(size_t)(k0 + kk) * ldw + nsrc0 + (lane & 31)]; }
    LDS_WAIT(); asm volatile("" ::: "memory");
    const int c = lane & 7;
#pragma unroll
    for (int j = 0; j < 4; ++j) { const int n = (lane >> 3) + 8 * j; const LAS float* s = scr + (8 * c) * 33 + n;
        v4u o; o.x = cvtpk(s[0 * 33], s[1 * 33]); o.y = cvtpk(s[2 * 33], s[3 * 33]); o.z = cvtpk(s[4 * 33], s[5 * 33]); o.w = cvtpk(s[6 * 33], s[7 * 33]);
        *(GAS v4u*)(WT + (size_t)(ndst0 + n) * ldt + kdst0 + k0 + 8 * c) = o; }
    LDS_WAIT(); asm volatile("" ::: "memory");
}
constexpr int IT_IN = 64 * (NIN / 32), IT_UQ = 16 * 96, IT_UKV = 8 * 128, IT_POOL = 4 * 8 * 16, IT_A = 32 * 128, IT_B = 32 * 128, IT_OUT = 64 * 128;
constexpr int IT_LAYER = IT_IN + IT_UQ + IT_UKV + IT_POOL + IT_A + IT_B + IT_OUT;
__device__ __forceinline__ void p0_prologue(Frame& F0) {
    struct { LAS unsigned char* lds; int tid, lane, wave, vcu, G; unsigned char* ws; const float* const* in; } F;
    F.lds = F0.lds; F.tid = F0.tid; asm volatile("" : "+v"(F.tid)); F.lane = F.tid & 63; F.wave = F0.wave; F.vcu = F0.vcu; F.G = F0.G; F.ws = F0.ws; F.in = F0.in;
    LAS float* scr = (LAS float*)(F.lds + RING_OFF + F.wave * 16384);
    const int gw = F.vcu * NWAVES + F.wave, NGW = F.G * NWAVES;
    for (int it = gw; it < DEPTH * IT_LAYER; it += NGW) {
        const int l = it / IT_LAYER; int r = it - l * IT_LAYER;
        bf16* wl = (bf16*)(F.ws + WS_W + (size_t)l * WL_SIZE);
        if (r < IT_IN) { const int kb = r / (NIN / 32), nb = r - kb * (NIN / 32), nd = nb * 32, k0 = kb * 64;
            bf16* WT = (bf16*)((unsigned char*)wl + WL_IN);
            if (nd >= IN_WIDTH) {
#pragma unroll
                for (int j = 0; j < 4; ++j) { const int q = j * 64 + F.lane, n = q >> 3, c = q & 7; *(GAS v4u*)(WT + (size_t)(nd + n) * 4096 + k0 + 8 * c) = (v4u){0u, 0u, 0u, 0u}; }
            } else { const int ns = nd < 1536 ? nd : (nd < PC_KR ? nd + 64 : nd - PC_KR + 1536);
                tr_item(F.in[I_WIN] + (size_t)l * 4096 * IN_WIDTH, IN_WIDTH, k0, ns, WT, 4096, nd, 0, scr, F.lane); }
            continue; }
        r -= IT_IN;
        if (r < IT_UQ) { const int kb = r / 96, nb = r - kb * 96; tr_item(F.in[I_WUQ] + (size_t)l * 1024 * 3072, 3072, kb * 64, nb * 32, (bf16*)((unsigned char*)wl + WL_UQ), 1024, nb * 32, 0, scr, F.lane); continue; }
        r -= IT_UQ;
        if (r < IT_UKV) { const int kb = r / 128, nb = r - kb * 128; tr_item(F.in[I_WUKV] + (size_t)l * 512 * 4096, 4096, kb * 64, nb * 32, (bf16*)((unsigned char*)wl + WL_UKV), 512, nb * 32, 0, scr, F.lane); continue; }
        r -= IT_UKV;
        if (r < IT_POOL) { const int g = r / 128, rr = r - g * 128, kb = rr / 16, nb = rr - kb * 16;
            tr_item(F.in[I_WPOOL] + ((size_t)l * 4 + g) * 512 * 512, 512, kb * 64, nb * 32, (bf16*)((unsigned char*)wl + WL_POOL), 512, g * 512 + nb * 32, 0, scr, F.lane); continue; }
        r -= IT_POOL;
        if (r < IT_A) { const int kb = r / 128, nb = r - kb * 128; tr_item(F.in[I_WA] + (size_t)l * 2048 * 4096, 4096, kb * 64, nb * 32, (bf16*)((unsigned char*)wl + WL_AB), 4096, nb * 32, 0, scr, F.lane); continue; }
        r -= IT_A;
        if (r < IT_B) { const int kb = r / 128, nb = r - kb * 128; tr_item(F.in[I_WB] + (size_t)l * 2048 * 4096, 4096, kb * 64, nb * 32, (bf16*)((unsigned char*)wl + WL_AB), 4096, nb * 32, 2048, scr, F.lane); continue; }
        r -= IT_B;
        { const int kb = r / 128, nb = r - kb * 128; tr_item(F.in[I_WOUT] + (size_t)l * 4096 * 4096, 4096, kb * 64, nb * 32, (bf16*)((unsigned char*)wl + WL_OUT), 4096, nb * 32, 0, scr, F.lane); }
    }
    const size_t gt = (size_t)(F.vcu) * (NWAVES * 64) + F.tid, NT = (size_t)F.G * NWAVES * 64;
    { float* H = (float*)(F.ws + WS_H);
      for (size_t i = gt; i < (size_t)MP * 1024; i += NT) { const int m = (int)(i >> 10), c4 = (int)(i & 1023); f32x4 v = (f32x4){0.f, 0.f, 0.f, 0.f};
          if (m < MROWS) { const int b = m / LSEQ, pos = m - b * LSEQ;
              v = pos < N_META ? *(const GAS f32x4*)(F.in[I_META] + (size_t)pos * 4096 + c4 * 4) : *(const GAS f32x4*)(F.in[I_X] + ((size_t)b * SEQ + (pos - N_META)) * 4096 + c4 * 4); }
          *(GAS f32x4*)(H + (size_t)m * 4096 + c4 * 4) = v; } }
    { float* TAB = (float*)(F.ws + WS_TAB);
      for (size_t i = gt; i < (size_t)LSEQ * 32; i += NT) { const int pos = (int)(i >> 5), fi = (int)(i & 31);
          const float inv = 1.0f / powf(10000.0f, (float)fi * (1.0f / 32.0f)); const float ang = (float)pos * inv;
          double rev = (double)ang * 0.15915494309189533577; rev -= rint(rev); const float rv = (float)rev;
          TAB[2 * i] = __builtin_amdgcn_cosf(rv); TAB[2 * i + 1] = __builtin_amdgcn_sinf(rv); } }
    { bf16* KA = (bf16*)(F.ws + WS_KA); bf16* VA = (bf16*)(F.ws + WS_VA);
      for (size_t i = gt; i < (size_t)64 * 48 * 24; i += NT) { const int bh = (int)(i / (48 * 24)), rr = (int)(i % (48 * 24)); *(GAS v4u*)(KA + ((size_t)bh * LP + 16) * 192 + rr * 8) = (v4u){0u, 0u, 0u, 0u}; }
      for (size_t i = gt; i < (size_t)64 * 48 * 16; i += NT) { const int bh = (int)(i / (48 * 16)), rr = (int)(i % (48 * 16)); *(GAS v4u*)(VA + ((size_t)bh * LP + 16) * 128 + rr * 8) = (v4u){0u, 0u, 0u, 0u}; } }
}

__device__ __forceinline__ void p1_rmsnorm(Frame& F0, const float* g) {
    struct { int lane, wave, vcu, G; unsigned char* ws; } F; F.lane = F0.lane; asm volatile("" : "+v"(F.lane)); F.wave = F0.wave; F.vcu = F0.vcu; F.G = F0.G; F.ws = F0.ws;
    const int gw = F.vcu * NWAVES + F.wave, NGW = F.G * NWAVES;
    const float* H = (const float*)(F.ws + WS_H); bf16* HN = (bf16*)(F.ws + WS_HN);
    for (int m = gw; m < MP; m += NGW) {
        const GAS f32x4* xr = (const GAS f32x4*)(H + (size_t)m * 4096) + F.lane;
        f32x4 v[16]; float ss = 0.f;
#pragma unroll
        for (int j = 0; j < 16; ++j) { v[j] = xr[64 * j]; ss += (v[j].x * v[j].x + v[j].y * v[j].y) + (v[j].z * v[j].z + v[j].w * v[j].w); }
        const float r = 1.0f / sqrtf(wave_sum(ss) * (1.0f / 4096.0f) + NORM_EPS);
        GAS v2u* o = (GAS v2u*)(HN + (size_t)m * 4096) + F.lane;
#pragma unroll
        for (int j = 0; j < 16; ++j) { const f32x4 gg = *((const GAS f32x4*)g + F.lane + 64 * j); v2u w; w.x = cvtpk(v[j].x * r * gg.x, v[j].y * r * gg.y); w.y = cvtpk(v[j].z * r * gg.z, v[j].w * r * gg.w); o[64 * j] = w; }
    }
}

__device__ __forceinline__ void unpack8(const v4u& u, float (&f)[8]) { f[0] = bflo(u.x); f[1] = bfhi(u.x); f[2] = bflo(u.y); f[3] = bfhi(u.y); f[4] = bflo(u.z); f[5] = bfhi(u.z); f[6] = bflo(u.w); f[7] = bfhi(u.w); }
__device__ __forceinline__ void p3_latent(Frame& F0, const float* qg, const float* kvg) {
    struct { int lane, wave, vcu, G; unsigned char* ws; } F; F.lane = F0.lane; asm volatile("" : "+v"(F.lane)); F.wave = F0.wave; F.vcu = F0.vcu; F.G = F0.G; F.ws = F0.ws;
    const int gw = F.vcu * NWAVES + F.wave, NGW = F.G * NWAVES;
    const bf16* PROJ = (const bf16*)(F.ws + WS_PROJ); bf16* CQN = (bf16*)(F.ws + WS_CQN); bf16* CKVN = (bf16*)(F.ws + WS_CKVN); bf16* DIFF = (bf16*)(F.ws + WS_DIFF);
    for (int m = gw; m < MP; m += NGW) {
        const bf16* pr = PROJ + (size_t)m * NIN;
        {
            float x[2][8]; float ss = 0.f;
#pragma unroll
            for (int j = 0; j < 2; ++j) { const v4u u = *(const GAS v4u*)(pr + PC_CQ + (j * 64 + F.lane) * 8); unpack8(u, x[j]);
#pragma unroll
                for (int e = 0; e < 8; ++e) ss += x[j][e] * x[j][e]; }
            const float r = 1.0f / sqrtf(wave_sum(ss) * (1.0f / 1024.0f) + NORM_EPS);
#pragma unroll
            for (int j = 0; j < 2; ++j) { const int c = (j * 64 + F.lane) * 8; const f32x4 g0 = *(const GAS f32x4*)(qg + c), g1 = *(const GAS f32x4*)(qg + c + 4);
                v4u w; w.x = cvtpk(x[j][0] * r * g0.x, x[j][1] * r * g0.y); w.y = cvtpk(x[j][2] * r * g0.z, x[j][3] * r * g0.w); w.z = cvtpk(x[j][4] * r * g1.x, x[j][5] * r * g1.y); w.w = cvtpk(x[j][6] * r * g1.z, x[j][7] * r * g1.w);
                *(GAS v4u*)(CQN + (size_t)m * 1024 + c) = w; }
        }
        {
            float x[8]; float ss = 0.f; const int c = F.lane * 8;
            const v4u u = *(const GAS v4u*)(pr + PC_CKV + c); unpack8(u, x);
#pragma unroll
            for (int e = 0; e < 8; ++e) ss += x[e] * x[e];
            const float r = 1.0f / sqrtf(wave_sum(ss) * (1.0f / 512.0f) + NORM_EPS);
            const f32x4 g0 = *(const GAS f32x4*)(kvg + c), g1 = *(const GAS f32x4*)(kvg + c + 4);
            v4u w; w.x = cvtpk(x[0] * r * g0.x, x[1] * r * g0.y); w.y = cvtpk(x[2] * r * g0.z, x[3] * r * g0.w); w.z = cvtpk(x[4] * r * g1.x, x[5] * r * g1.y); w.w = cvtpk(x[6] * r * g1.z, x[7] * r * g1.w);
            *(GAS v4u*)(CKVN + (size_t)m * 512 + c) = w;
        }
        {
            const int b = m / LSEQ, pos = m - b * LSEQ; const bool valid = m < MROWS;
#pragma unroll
            for (int j = 0; j < 4; ++j) { const int c = (j * 64 + F.lane) * 8; const int w = 2 << j; const int n = valid ? (pos + 1 < w ? pos + 1 : w) : 1;
                const bf16* up = pr + PC_U + c; float u0[8], acc[8];
                { const v4u u = *(const GAS v4u*)up; unpack8(u, u0); }
#pragma unroll
                for (int e = 0; e < 8; ++e) acc[e] = u0[e];
                for (int i = 1; i < n; ++i) { float t[8]; const v4u u = *(const GAS v4u*)(up - (size_t)i * NIN); unpack8(u, t);
#pragma unroll
                    for (int e = 0; e < 8; ++e) acc[e] += t[e]; }
                const float rn = 1.0f / (float)n; float d[8];
#pragma unroll
                for (int e = 0; e < 8; ++e) d[e] = valid ? acc[e] * rn - u0[e] : 0.f;
                v4u o; o.x = cvtpk(d[0], d[1]); o.y = cvtpk(d[2], d[3]); o.z = cvtpk(d[4], d[5]); o.w = cvtpk(d[6], d[7]);
                *(GAS v4u*)(DIFF + (size_t)m * 2048 + c) = o; }
        }
    }
}

__device__ __forceinline__ void p5_qknorm(Frame& F0, const float* qhg, const float* khg) {
    struct { int lane, wave, vcu, G; unsigned char* ws; } F; F.lane = F0.lane; asm volatile("" : "+v"(F.lane)); F.wave = F0.wave; F.vcu = F0.vcu; F.G = F0.G; F.ws = F0.ws;
    const int gw = F.vcu * NWAVES + F.wave, NGW = F.G * NWAVES;
    const bf16* PROJ = (const bf16*)(F.ws + WS_PROJ); const bf16* QRAW = (const bf16*)(F.ws + WS_QRAW); const bf16* KRAW = (const bf16*)(F.ws + WS_KRAW);
    bf16* QA = (bf16*)(F.ws + WS_QA); bf16* KA = (bf16*)(F.ws + WS_KA); const float* TAB = (const float*)(F.ws + WS_TAB);
    const int j = F.lane & 31, half = F.lane >> 5;
    float gq[6], gk[6];
#pragma unroll
    for (int t = 0; t < 3; ++t) { gq[2 * t] = qhg[64 * t + 2 * j]; gq[2 * t + 1] = qhg[64 * t + 2 * j + 1]; gk[2 * t] = khg[64 * t + 2 * j]; gk[2 * t + 1] = khg[64 * t + 2 * j + 1]; }
    const int fi = (2 * j) & 31;
    for (int m = gw; m < MROWS; m += NGW) {
        const int b = m / LSEQ, pos = m - b * LSEQ, pp = pos < N_META ? pos : pos + 48;
        const f32x4 cs = *(const GAS f32x4*)(TAB + ((size_t)pos * 32 + fi) * 2);
        const unsigned kr = *(const GAS unsigned*)(PROJ + (size_t)m * NIN + PC_KR + 2 * j);
#pragma unroll 2
        for (int it = 0; it < 8; ++it) { const int h = 2 * it + half;
            {
                const bf16* src = QRAW + (size_t)m * 3072 + h * 192 + 2 * j;
                const unsigned u0 = *(const GAS unsigned*)src, u1 = *(const GAS unsigned*)(src + 64), u2 = *(const GAS unsigned*)(src + 128);
                float x[6] = {bflo(u0), bfhi(u0), bflo(u1), bfhi(u1), bflo(u2), bfhi(u2)};
                float ss = 0.f;
#pragma unroll
                for (int e = 0; e < 6; ++e) ss += x[e] * x[e];
#pragma unroll
                for (int o = 1; o < 32; o <<= 1) ss += __shfl_xor(ss, o);
                const float r = 1.0f / sqrtf(ss * (1.0f / 192.0f) + NORM_EPS);
#pragma unroll
                for (int e = 0; e < 6; ++e) x[e] = x[e] * r * gq[e];
                const float p0 = __shfl_xor(x[4], 16), p1 = __shfl_xor(x[5], 16);
                const float y0 = j < 16 ? x[4] * cs.x - p0 * cs.y : x[4] * cs.x + p0 * cs.y;
                const float y1 = j < 16 ? x[5] * cs.z - p1 * cs.w : x[5] * cs.z + p1 * cs.w;
                bf16* dst = QA + ((size_t)(b * 16 + h) * LP + pp) * 192 + 2 * j;
                *(GAS unsigned*)dst = cvtpk(x[0], x[1]); *(GAS unsigned*)(dst + 64) = cvtpk(x[2], x[3]); *(GAS unsigned*)(dst + 128) = cvtpk(y0, y1);
            }
            {
                const bf16* src = KRAW + (size_t)m * 2048 + h * 128 + 2 * j;
                const unsigned u0 = *(const GAS unsigned*)src, u1 = *(const GAS unsigned*)(src + 64);
                float x[6] = {bflo(u0), bfhi(u0), bflo(u1), bfhi(u1), bflo(kr), bfhi(kr)};
                float ss = 0.f;
#pragma unroll
                for (int e = 0; e < 6; ++e) ss += x[e] * x[e];
#pragma unroll
                for (int o = 1; o < 32; o <<= 1) ss += __shfl_xor(ss, o);
                const float r = 1.0f / sqrtf(ss * (1.0f / 192.0f) + NORM_EPS);
#pragma unroll
                for (int e = 0; e < 6; ++e) x[e] = x[e] * r * gk[e];
                const float p0 = __shfl_xor(x[4], 16), p1 = __shfl_xor(x[5], 16);
                const float y0 = j < 16 ? x[4] * cs.x - p0 * cs.y : x[4] * cs.x + p0 * cs.y;
                const float y1 = j < 16 ? x[5] * cs.z - p1 * cs.w : x[5] * cs.z + p1 * cs.w;
                bf16* dst = KA + ((size_t)(b * 16 + h) * LP + pp) * 192 + 2 * j;
                *(GAS unsigned*)dst = cvtpk(x[0], x[1]); *(GAS unsigned*)(dst + 64) = cvtpk(x[2], x[3]); *(GAS unsigned*)(dst + 128) = cvtpk(y0, y1);
            }
        }
    }
}

namespace att {
constexpr int KROW = 400, SHM_K = 64 * KROW, SHM_V = 64 * 128 * 2;
constexpr int OFF_V = 0, OFF_K = 2 * SHM_V, OFF_WS = OFF_K + 2 * SHM_K, ATT_LDS = OFF_WS + NWAVES * 64 * 4;
static_assert(ATT_LDS <= RING_BYTES, "attention LDS");
constexpr float SCALE = 0.07216878364870322f;
__device__ __forceinline__ int crow(int r, int hi) { return (r & 3) + 8 * (r >> 2) + 4 * hi; }
__device__ __forceinline__ int v_st(int k, int c) { const int kk = (k & ~0xC) | ((k & 4) << 1) | ((k & 8) >> 1); return ((kk >> 3) * 4 + (c >> 5)) * 512 + ((kk & 7) * 32 + (c & 31)) * 2; }
__device__ __forceinline__ int v_rd_base(int lane) { return ((lane & 3) << 3) | (((lane >> 2) & 3) << 6) | (((lane >> 4) & 1) << 5) | (((lane >> 5) & 1) << 8); }
constexpr int v_rd_off(int d0, int ks, int half) { return d0 * 512 + ks * 4096 + half * 2048; }
template <int OFF> __device__ __forceinline__ s16x4 tr_read(int vb) { s16x4 r; asm volatile("ds_read_b64_tr_b16 %0, %1 offset:%2" : "=&v"(r) : "v"(vb), "i"(OFF) : "memory"); return r; }
template <int D0> __device__ __forceinline__ void pv_one(f32x16& od, int vb, bf16x8 pa0, bf16x8 pa1, bf16x8 pa2, bf16x8 pa3) {
    const s16x4 l0 = tr_read<v_rd_off(D0, 0, 0)>(vb), h0 = tr_read<v_rd_off(D0, 0, 1)>(vb), l1 = tr_read<v_rd_off(D0, 1, 0)>(vb), h1 = tr_read<v_rd_off(D0, 1, 1)>(vb);
    const s16x4 l2 = tr_read<v_rd_off(D0, 2, 0)>(vb), h2 = tr_read<v_rd_off(D0, 2, 1)>(vb), l3 = tr_read<v_rd_off(D0, 3, 0)>(vb), h3 = tr_read<v_rd_off(D0, 3, 1)>(vb);
    asm volatile("s_waitcnt lgkmcnt(0)" ::: "memory"); __builtin_amdgcn_sched_barrier(0);
#define PK(L, H) (bf16x8){L[0], L[1], L[2], L[3], H[0], H[1], H[2], H[3]}
    od = __builtin_amdgcn_mfma_f32_32x32x16_bf16(pa0, PK(l0, h0), od, 0, 0, 0);
    od = __builtin_amdgcn_mfma_f32_32x32x16_bf16(pa1, PK(l1, h1), od, 0, 0, 0);
    od = __builtin_amdgcn_mfma_f32_32x32x16_bf16(pa2, PK(l2, h2), od, 0, 0, 0);
    od = __builtin_amdgcn_mfma_f32_32x32x16_bf16(pa3, PK(l3, h3), od, 0, 0, 0);
#undef PK
}
__device__ __forceinline__ void attn_unit(const bf16* Qb, const bf16* Kh, const bf16* Vh, int NT, int lw, bf16* XA, const bf16* GA, int m0, int nrows_out, LAS unsigned char* lds) {
    int tid = threadIdx.x; asm volatile("" : "+v"(tid));
    const int wid = __builtin_amdgcn_readfirstlane(tid >> 6), lane = tid & 63, r32 = lane & 31, hi = lane >> 5;
    LAS unsigned char* V_lds = lds + OFF_V; LAS unsigned char* K_lds = lds + OFF_K;
    LAS float* wsf = (LAS float*)(lds + OFF_WS) + wid * 64; LAS float* li_l = wsf; LAS float* al_l = wsf + 32;
    float m_reg = -1e30f, l_reg = 0.f; f32x16 o[4];
#pragma unroll
    for (int d = 0; d < 4; ++d)
#pragma unroll
        for (int r = 0; r < 16; ++r) o[d][r] = 0.f;
    bf16x8 qr[12];
    { const bf16* Qw = Qb + (size_t)(wid * 32 + r32) * QKD + hi * 8;
#pragma unroll
      for (int d0 = 0; d0 < 12; ++d0) qr[d0] = *(const GAS bf16x8*)(Qw + d0 * 16); }
    const int sr = tid >> 4, sc = (tid & 15) * 8, vst0 = v_st(sr, sc), vst1 = v_st(32 + sr, sc);
    unsigned kgo[3], klo[3];
#pragma unroll
    for (int i = 0; i < 3; ++i) { const int id = tid + 512 * i, kr_ = id / 24, kc_ = id - kr_ * 24; kgo[i] = (unsigned)(kr_ * (QKD * 2) + kc_ * 16); klo[i] = (unsigned)(kr_ * KROW + kc_ * 16); }
    const unsigned vgo0 = (unsigned)(sr * (VD * 2) + sc * 2), vgo1 = vgo0 + 32u * (VD * 2);
    const int vb0 = (int)(uintptr_t)(V_lds) + v_rd_base(lane);
    bf16x8 vs0, vs1, ks0, ks1, ks2;
    const GAS unsigned char* Kg = (const GAS unsigned char*)Kh; const GAS unsigned char* Vg = (const GAS unsigned char*)Vh;
#define SLOAD(k0) do { const GAS unsigned char* kt_ = Kg + (size_t)(k0) * (QKD * 2); const GAS unsigned char* vt_ = Vg + (size_t)(k0) * (VD * 2); \
        vs0 = *(const GAS bf16x8*)(vt_ + vgo0); vs1 = *(const GAS bf16x8*)(vt_ + vgo1); \
        ks0 = *(const GAS bf16x8*)(kt_ + kgo[0]); ks1 = *(const GAS bf16x8*)(kt_ + kgo[1]); ks2 = *(const GAS bf16x8*)(kt_ + kgo[2]); } while (0)
#define SWRITE(b) do { *(LAS bf16x8*)(V_lds + (b) * SHM_V + vst0) = vs0; *(LAS bf16x8*)(V_lds + (b) * SHM_V + vst1) = vs1; \
        *(LAS bf16x8*)(K_lds + (b) * SHM_K + klo[0]) = ks0; *(LAS bf16x8*)(K_lds + (b) * SHM_K + klo[1]) = ks1; *(LAS bf16x8*)(K_lds + (b) * SHM_K + klo[2]) = ks2; } while (0)
    constexpr float C = SCALE * 1.4426950408889634f;
    SLOAD(0);
    for (int j = 0; j < NT; ++j) {
        const int buf = j & 1;
        asm volatile("s_waitcnt vmcnt(0)" ::: "memory");
        SWRITE(buf);
        if (j + 1 < NT) SLOAD((j + 1) * 64);
        WG_BAR();
        if (j <= lw) {
            f32x16 p0, p1;
#pragma unroll
            for (int r = 0; r < 16; ++r) { p0[r] = 0.f; p1[r] = 0.f; }
            { const LAS unsigned char* Kb = K_lds + buf * SHM_K + r32 * KROW + hi * 16;
#pragma unroll
              for (int d0 = 0; d0 < 12; ++d0) { const bf16x8 b0 = *(const LAS bf16x8*)(Kb + d0 * 32), b1 = *(const LAS bf16x8*)(Kb + 32 * KROW + d0 * 32);
                  p0 = __builtin_amdgcn_mfma_f32_32x32x16_bf16(b0, qr[d0], p0, 0, 0, 0); p1 = __builtin_amdgcn_mfma_f32_32x32x16_bf16(b1, qr[d0], p1, 0, 0, 0); } }
            if (j == 0) {
#pragma unroll
                for (int r = 8; r < 16; ++r) p0[r] = -1e30f;
#pragma unroll
                for (int r = 0; r < 16; ++r) p1[r] = -1e30f; }
            float pmax = p0[0];
#pragma unroll
            for (int r = 1; r < 16; ++r) pmax = fmaxf(pmax, p0[r]);
#pragma unroll
            for (int r = 0; r < 16; ++r) pmax = fmaxf(pmax, p1[r]);
            { auto rr = __builtin_amdgcn_permlane32_swap(__float_as_uint(pmax), __float_as_uint(pmax), false, false); pmax = fmaxf(__uint_as_float(rr[0]), __uint_as_float(rr[1])); }
            const float mn = fmaxf(m_reg, pmax); const float alpha = __builtin_amdgcn_exp2f((m_reg - mn) * C); m_reg = mn;
            const float mnC = -mn * C;
#pragma unroll
            for (int r = 0; r < 16; ++r) { p0[r] = __builtin_amdgcn_exp2f(fmaf(p0[r], C, mnC)); p1[r] = __builtin_amdgcn_exp2f(fmaf(p1[r], C, mnC)); }
            float ps = 0.f;
#pragma unroll
            for (int r = 0; r < 16; ++r) ps += p0[r];
#pragma unroll
            for (int r = 0; r < 16; ++r) ps += p1[r];
            { auto rr = __builtin_amdgcn_permlane32_swap(__float_as_uint(ps), __float_as_uint(ps), false, false); ps = __uint_as_float(rr[0]) + __uint_as_float(rr[1]); }
            l_reg = l_reg * alpha + ps;
            if (__any(alpha < 1.f)) { if (hi == 0) al_l[r32] = alpha; asm volatile("s_waitcnt lgkmcnt(0)" ::: "memory");
#pragma unroll
                for (int r = 0; r < 16; ++r) { const float a = al_l[crow(r, hi)];
#pragma unroll
                    for (int d = 0; d < 4; ++d) o[d][r] *= a; } }
            bf16x8 pa0, pa1, pa2, pa3;
#define PK4(P, BASE, OUT) do { unsigned a0 = cvtpk(P[BASE + 0], P[BASE + 1]), a1 = cvtpk(P[BASE + 2], P[BASE + 3]); \
            unsigned b0 = cvtpk(P[BASE + 4], P[BASE + 5]), b1 = cvtpk(P[BASE + 6], P[BASE + 7]); \
            auto r0 = __builtin_amdgcn_permlane32_swap(a0, b0, false, false); auto r1 = __builtin_amdgcn_permlane32_swap(a1, b1, false, false); \
            v4u w = {r0[0], r1[0], r0[1], r1[1]}; OUT = *reinterpret_cast<bf16x8*>(&w); } while (0)
            PK4(p0, 0, pa0); PK4(p0, 8, pa1); PK4(p1, 0, pa2); PK4(p1, 8, pa3);
#undef PK4
            const int vb = vb0 + buf * SHM_V;
            pv_one<0>(o[0], vb, pa0, pa1, pa2, pa3); pv_one<1>(o[1], vb, pa0, pa1, pa2, pa3); pv_one<2>(o[2], vb, pa0, pa1, pa2, pa3); pv_one<3>(o[3], vb, pa0, pa1, pa2, pa3);
        }
    }
#undef SLOAD
#undef SWRITE
    if (hi == 0) li_l[r32] = l_reg;
    asm volatile("s_waitcnt lgkmcnt(0)" ::: "memory");
    int lane_o = lane; asm volatile("" : "+v"(lane_o));
    const int r32o = lane_o & 31, hio = lane_o >> 5;
    GAS unsigned char* xg = (GAS unsigned char*)XA; const GAS unsigned char* gg = (const GAS unsigned char*)GA;
#pragma unroll
    for (int r = 0; r < 16; ++r) { const int orow = crow(r, hio), i = wid * 32 + orow; const float rl = __builtin_amdgcn_rcpf(li_l[orow]);
        if (i < nrows_out) { const unsigned m = (unsigned)(m0 + i); const unsigned xo = m * 8192u + (unsigned)r32o * 2u, go = m * (unsigned)(NIN * 2) + (unsigned)r32o * 2u;
#pragma unroll
            for (int d0 = 0; d0 < 4; ++d0) { const float g = __uint_as_float(((unsigned)*(const GAS unsigned short*)(gg + go + d0 * 64)) << 16);
                const float val = o[d0][r] * rl * g; *(GAS unsigned short*)(xg + xo + d0 * 64) = (unsigned short)(cvtpk(val, val) & 0xffffu); } } }
    WG_BAR();
}
__device__ __forceinline__ void attn_phase(Frame& F) {
    const bf16* QA = (const bf16*)(F.ws + WS_QA); const bf16* KA = (const bf16*)(F.ws + WS_KA); const bf16* VA = (const bf16*)(F.ws + WS_VA);
    bf16* XAB = (bf16*)(F.ws + WS_XAB); const bf16* PROJ = (const bf16*)(F.ws + WS_PROJ);
    LAS unsigned char* lds = F.lds + RING_OFF;
    const int wid = F.wave;
    const int npair = (512 - F.vcu + F.G - 1) / F.G, nmeta = F.vcu < 64 ? (64 - F.vcu + F.G - 1) / F.G : 0;
#pragma unroll 1
    for (int u = 0; u < 2 * npair + nmeta; ++u) {
        int bh, qoff, NT, lw, m0, nro;
        if (u < 2 * npair) { const int p = F.vcu + (u >> 1) * F.G, pi = p & 7, qb = (u & 1) ? pi : 15 - pi; bh = p >> 3;
            qoff = 64 + 256 * qb; NT = 4 * qb + 5; lw = 4 * qb + 1 + (wid >> 1); m0 = (bh >> 4) * LSEQ + N_META + 256 * qb; nro = 256; }
        else { bh = F.vcu + (u - 2 * npair) * F.G; qoff = 0; NT = 1; lw = wid == 0 ? 0 : -1; m0 = (bh >> 4) * LSEQ; nro = 16; }
        const int h = bh & 15;
        attn_unit(QA + ((size_t)bh * LP + qoff) * QKD, KA + (size_t)bh * LP * QKD, VA + (size_t)bh * LP * VD, NT, lw, XAB + h * 128, PROJ + PC_GA + h * 128, m0, nro, lds);
    }
}
}

struct Args { const float* in[15]; float* out; unsigned char* ws; int ph_lo, ph_hi; };
constexpr int NPHASE = 1 + 8 * DEPTH;

__global__ void __launch_bounds__(NWAVES * 64, 2) trunk_fwd(Args args) {
    extern __shared__ __attribute__((aligned(16))) unsigned char lds_raw[];
    Frame F;
    F.lds = (LAS unsigned char*)lds_raw;
    F.tid = threadIdx.x; F.lane = F.tid & 63; F.wave = __builtin_amdgcn_readfirstlane(F.tid >> 6);
    F.G = gridDim.x; { const int bx = blockIdx.x; F.vcu = (F.G % 8 == 0) ? (bx % 8) * (F.G / 8) + bx / 8 : bx; }
    F.ws = args.ws; F.out = args.out;
#pragma unroll
    for (int i = 0; i < 15; ++i) F.in[i] = args.in[i];
    volatile LAS unsigned* MISC = (volatile LAS unsigned*)(F.lds + MISC_OFF);
    for (int u = F.tid; u < (LDS_BYTES - LDSCTL_OFF) / 4; u += NWAVES * 64) ((LAS unsigned*)(F.lds + LDSCTL_OFF))[u] = 0u;
    __syncthreads();
    unsigned* ctl = (unsigned*)(F.ws + WS_CTL);
    XcdBarrier bar; bar.bar = ctl + CW_BAR; bar.x = 0; bar.st = nullptr;
    if (!MK_PER_PHASE) bar = xcd_barrier_post(ctl + CW_BAR, MISC + 8);
    const int lo = args.ph_lo, hi = args.ph_hi;
#define IN(k) (lo <= (k) && (k) < hi)
#ifndef PHMASK
#define PHMASK 0xFFFF
#endif
#define EN(b) ((PHMASK >> (b)) & 1)
#define SEAM(k) do { if (!MK_PER_PHASE && IN((k) + 1)) xcd_barrier(bar); } while (0)

    if (EN(0) && IN(0)) { p0_prologue(F); SEAM(0); }

    for (int l = 0; l < DEPTH; ++l) {
        const int pb = 1 + 8 * l;
        unsigned char* wl = F.ws + WS_W + (size_t)l * WL_SIZE;
        bf16* PROJ = (bf16*)(F.ws + WS_PROJ);
        if (EN(1) && IN(pb + 0)) { p1_rmsnorm(F, F.in[I_NORMG] + (size_t)l * 4096); SEAM(pb + 0); }
        if (EN(2) && IN(pb + 1)) {
            pg8::Gemm g{(const bf16*)(F.ws + WS_HN), (const bf16*)(wl + WL_IN), 4096, 4096, 4096}; pg8::StaticOrder S; S.init(MP, NIN, F.G, (int)blockIdx.x);
            pg8::EpiProj E{PROJ, NIN, 14, 30, 30, 62};
            pg8::gemm_phase<pg8::EpiProj, pg8::StaticOrder, PG8_ALIGN, PG8_SP2>(F.lds + RING_OFF, g, S, E);
            SEAM(pb + 1); }
        if (EN(3) && IN(pb + 2)) { p3_latent(F, F.in[I_QLG] + (size_t)l * 1024, F.in[I_KVLG] + (size_t)l * 512); SEAM(pb + 2); }
        if (IN(pb + 3)) {
            if (EN(4)) {
                pg8::Gemm g{(const bf16*)(F.ws + WS_CQN), (const bf16*)(wl + WL_UQ), 1024, 1024, 1024}; pg8::StaticOrder S; S.init(MP, 3072, F.G, (int)blockIdx.x);
                pg8::EpiProj E{(bf16*)(F.ws + WS_QRAW), 3072, 0, 0, 0, 0};
                pg8::gemm_phase<pg8::EpiProj, pg8::StaticOrder, PG8_ALIGN, PG8_SP2>(F.lds + RING_OFF, g, S, E); }
            if (EN(5)) {
                pg8::Gemm g{(const bf16*)(F.ws + WS_CKVN), (const bf16*)(wl + WL_UKV), 512, 512, 512}; pg8::StaticOrder S; S.init(MP, 4096, F.G, (int)blockIdx.x);
                pg8::EpiKV E{(bf16*)(F.ws + WS_KRAW), (bf16*)(F.ws + WS_VA), LP};
                pg8::gemm_phase<pg8::EpiKV, pg8::StaticOrder, PG8_ALIGN, PG8_SP2>(F.lds + RING_OFF, g, S, E); }
            if (EN(6)) {
                pg8::Gemm g{(const bf16*)(F.ws + WS_DIFF), (const bf16*)(wl + WL_POOL), 2048, 512, 512}; pg8::PoolOrder S; S.init(MP, 2048, F.G, (int)blockIdx.x);
                pg8::EpiPool E{(bf16*)(F.ws + WS_XAB) + 2048, PROJ + PC_GB, NIN, F.in[I_PSCALE] + (size_t)l * 2048};
                pg8::gemm_phase<pg8::EpiPool, pg8::PoolOrder, PG8_ALIGN, PG8_SP2>(F.lds + RING_OFF, g, S, E); }
            SEAM(pb + 3); }
        if (EN(7) && IN(pb + 4)) { p5_qknorm(F, F.in[I_QHG] + (size_t)l * 192, F.in[I_KHG] + (size_t)l * 192); SEAM(pb + 4); }
                if (EN(8) && IN(pb + 5)) { att::attn_phase(F); SEAM(pb + 5); }
        if (IN(pb + 6)) {
            if (EN(9)) {
                pg8::Gemm g{(const bf16*)(F.ws + WS_XAB), (const bf16*)(wl + WL_AB), 4096, 4096, 2048}; pg8::StaticOrder S; S.init(MP, 4096, F.G, (int)blockIdx.x);
                pg8::EpiT1 E{(float*)(F.ws + WS_T1), PROJ + PC_MA, NIN};
                pg8::gemm_phase<pg8::EpiT1, pg8::StaticOrder, PG8_ALIGN, PG8_SP2>(F.lds + RING_OFF, g, S, E); }
            if (EN(10)) {
                pg8::Gemm g{(const bf16*)(F.ws + WS_XAB) + 2048, (const bf16*)(wl + WL_AB) + 2048, 4096, 4096, 2048}; pg8::StaticOrder S; S.init(MP, 4096, F.G, (int)blockIdx.x);
                pg8::EpiMerge E{(const float*)(F.ws + WS_T1), PROJ + PC_MB, NIN, (bf16*)(F.ws + WS_MG)};
                pg8::gemm_phase<pg8::EpiMerge, pg8::StaticOrder, PG8_ALIGN, PG8_SP2>(F.lds + RING_OFF, g, S, E); }
            SEAM(pb + 6); }
        if (EN(11) && IN(pb + 7)) {
            pg8::Gemm g{(const bf16*)(F.ws + WS_MG), (const bf16*)(wl + WL_OUT), 4096, 4096, 4096}; pg8::StaticOrder S; S.init(MP, 4096, F.G, (int)blockIdx.x);
            pg8::EpiRes E{(float*)(F.ws + WS_H), l == DEPTH - 1 ? F.out : nullptr};
            pg8::gemm_phase<pg8::EpiRes, pg8::StaticOrder, PG8_ALIGN, PG8_SP2>(F.lds + RING_OFF, g, S, E);
            SEAM(pb + 7); }
    }
#undef IN
#undef SEAM
}

extern "C" void kernel_launch(void* const* d_in, const int* in_sizes, int n_in, void* d_out, int out_size, void* d_ws, size_t ws_size, hipStream_t stream) {
    static int grid = 0;
    if (grid == 0) {
        if (n_in != 15 || out_size != BATCH * SEQ * D_MODEL || ws_size < WS_END) { fprintf(stderr, "kernel_launch: unexpected shapes (n_in %d out %d ws %zu need %zu)\n", n_in, out_size, ws_size, (size_t)WS_END); grid = -1; return; }
        int dev = 0, cus = 0, per_cu = 0;
        if (hipGetDevice(&dev) != hipSuccess || hipDeviceGetAttribute(&cus, hipDeviceAttributeMultiprocessorCount, dev) != hipSuccess) { grid = -1; return; }
        if (hipFuncSetAttribute((const void*)trunk_fwd, hipFuncAttributeMaxDynamicSharedMemorySize, LDS_BYTES) != hipSuccess) { fprintf(stderr, "kernel_launch: hipFuncSetAttribute failed\n"); grid = -1; return; }
        if (hipOccupancyMaxActiveBlocksPerMultiprocessor(&per_cu, (const void*)trunk_fwd, NWAVES * 64, LDS_BYTES) != hipSuccess || per_cu < 1) fprintf(stderr, "kernel_launch: occupancy query says %d\n", per_cu);
        (void)hipGetLastError();
        grid = cus;
    }
    if (grid < 0) return;
    if (hipMemsetAsync((char*)d_ws + WS_CTL, 0, CTL_ZERO_BYTES, stream) != hipSuccess) return;
    Args a{};
    for (int i = 0; i < 15; ++i) a.in[i] = (const float*)d_in[i];
    a.out = (float*)d_out; a.ws = (unsigned char*)d_ws;
#if MK_PER_PHASE
    for (int p = 0; p < NPHASE; ++p) { a.ph_lo = p; a.ph_hi = p + 1; hipLaunchKernelGGL(trunk_fwd, dim3(grid), dim3(NWAVES * 64), LDS_BYTES, stream, a); }
#else
    a.ph_lo = 0; a.ph_hi = NPHASE; hipLaunchKernelGGL(trunk_fwd, dim3(grid), dim3(NWAVES * 64), LDS_BYTES, stream, a);
#endif
    (void)in_sizes;
}
```

```cpp
#include <hip/hip_runtime.h>
#include <cstdio>
#include <cstdint>

#ifndef MK_PER_PHASE
#define MK_PER_PHASE 0
#endif

namespace pg8 {
#define PG8_LAS __attribute__((address_space(3)))
typedef unsigned short bf16_t;
typedef short bf16x8 __attribute__((ext_vector_type(8)));
typedef float f32x4 __attribute__((ext_vector_type(4)));
typedef unsigned u32x4 __attribute__((ext_vector_type(4)));
constexpr int BM = 256, BK = 64, HALF = 128, HTB = HALF * BK * 2  , STAGE_BYTES = 8 * HTB, NXCD = 8, WGM = 8;

__host__ __device__ __forceinline__ int lds_byte(int r, int c) { const int st = (r >> 4) * 2 + (c >> 5), rr = r & 15, cc = c & 31, ob = rr * 64 + cc * 2; return st * 1024 + (ob ^ (((ob >> 9) & 1) << 5)); }
__host__ __device__ __forceinline__ void stage_rc(int b, int& R, int& C) { const int st = b / 1024, sb = b % 1024, swz = sb ^ (((sb >> 9) & 1) << 5); R = (st >> 1) * 16 + swz / 64; C = (st & 1) * 32 + (swz % 64) / 2; }
__host__ __device__ __forceinline__ int perm32(int rho) { const int n = rho >> 4, i = rho & 15; return 8 * (i >> 2) + 4 * n + (i & 3); }

struct Unit { int pm, pn; unsigned aoff; };
struct Gemm { const bf16_t* A; const bf16_t* Bt; int lda, ldb, K; };

struct StaticOrder {
    int nM, nN, nwg, G, c;
    __host__ __device__ void init(int M, int N, int G_, int c_) { nM = M / BM; nN = N / BM; nwg = nM * nN; G = G_; c = c_; }
    __host__ __device__ bool next(int i, Unit& u) const {
        const long L = (long)i * G + c; if (L >= nwg) return false;
        int wgid = (int)L; { const int q = nwg / NXCD, r = nwg % NXCD, xcd = wgid % NXCD, off = wgid / NXCD; wgid = (xcd < r ? xcd * (q + 1) : r * (q + 1) + (xcd - r) * q) + off; }
        const int nig = WGM * nN, gid = wgid / nig, fm = gid * WGM, gsz = (nM - fm) < WGM ? (nM - fm) : WGM;
        u.pm = fm + ((wgid % nig) % gsz); u.pn = (wgid % nig) / gsz; u.aoff = 0u; return true;
    }
    __device__ __forceinline__ void a_ready(const Unit&) const {}
    __device__ __forceinline__ void done(const Unit&) const {}
};
__device__ __forceinline__ unsigned cvt_pk_bf16(float lo, float hi) { unsigned r; asm volatile("v_cvt_pk_bf16_f32 %0, %1, %2" : "=v"(r) : "v"(lo), "v"(hi)); return r; }
typedef unsigned u32x2 __attribute__((ext_vector_type(2)));
__device__ __forceinline__ float bflo(unsigned u) { return __uint_as_float(u << 16); }
__device__ __forceinline__ float bfhi(unsigned u) { return __uint_as_float(u & 0xffff0000u); }
__device__ __forceinline__ float sigmoidf_(float x) { return __builtin_amdgcn_rcpf(1.0f + __builtin_amdgcn_exp2f(-1.4426950408889634f * x)); }


struct EpiProj {
    static constexpr bool PERM = true, AFTER_DRAIN = false, MID = false;
    bf16_t* O; int ldc; int silu_lo, silu_hi, sig_lo, sig_hi; const float* ss;
    __device__ __forceinline__ void operator()(const f32x4 (&acc)[2][2][4][2], const Unit& u, int wr, int wc, int fr, int fq) const {
        const int row0 = u.pm * BM + wr * 64 + fr; const int col0 = u.pn * BM + wc * 32 + 8 * fq;
        const int act = (u.pn >= silu_lo && u.pn < silu_hi) ? 1 : ((u.pn >= sig_lo && u.pn < sig_hi) ? 2 : 0);
#pragma unroll
        for (int ai = 0; ai < 2; ++ai)
#pragma unroll
            for (int m = 0; m < 4; ++m) { const int row = row0 + ai * HALF + m * 16; bf16_t* rowp = O + (size_t)row * ldc + col0;
                const float r = ss ? 1.0f / sqrtf(ss[row] * (1.0f / 4096.0f) + 1e-6f) : 1.0f;
#pragma unroll
                for (int bj = 0; bj < 2; ++bj) { f32x4 v0 = acc[ai][bj][m][0] * r, v1 = acc[ai][bj][m][1] * r;
                    if (act) {
#pragma unroll
                        for (int j = 0; j < 4; ++j) { const float s0 = sigmoidf_(v0[j]), s1 = sigmoidf_(v1[j]); v0[j] = (act == 1) ? v0[j] * s0 : s0; v1[j] = (act == 1) ? v1[j] * s1 : s1; } }
                    u32x4 w; w.x = cvt_pk_bf16(v0[0], v0[1]); w.y = cvt_pk_bf16(v0[2], v0[3]); w.z = cvt_pk_bf16(v1[0], v1[1]); w.w = cvt_pk_bf16(v1[2], v1[3]);
                    *(u32x4*)(rowp + bj * HALF) = w; } }
    }
};
struct EpiKV {
    static constexpr bool PERM = true, AFTER_DRAIN = false, MID = false;
    bf16_t* KRAW; bf16_t* VA; int lp;
    __device__ __forceinline__ void operator()(const f32x4 (&acc)[2][2][4][2], const Unit& u, int wr, int wc, int fr, int fq) const {
        const int row0 = u.pm * BM + wr * 64 + fr; const int h = u.pn; const int c0 = wc * 32 + 8 * fq;
#pragma unroll
        for (int ai = 0; ai < 2; ++ai)
#pragma unroll
            for (int m = 0; m < 4; ++m) { const int row = row0 + ai * HALF + m * 16;
                { const f32x4 v0 = acc[ai][0][m][0], v1 = acc[ai][0][m][1]; u32x4 w; w.x = cvt_pk_bf16(v0[0], v0[1]); w.y = cvt_pk_bf16(v0[2], v0[3]); w.z = cvt_pk_bf16(v1[0], v1[1]); w.w = cvt_pk_bf16(v1[2], v1[3]);
                  *(u32x4*)(KRAW + (size_t)row * 2048 + h * 128 + c0) = w; }
                { const int b = row >> 12, pp = 64 + (row & 4095);
                  const f32x4 v0 = acc[ai][1][m][0], v1 = acc[ai][1][m][1]; u32x4 w; w.x = cvt_pk_bf16(v0[0], v0[1]); w.y = cvt_pk_bf16(v0[2], v0[3]); w.z = cvt_pk_bf16(v1[0], v1[1]); w.w = cvt_pk_bf16(v1[2], v1[3]);
                  *(u32x4*)(VA + ((size_t)(b * 16 + h) * lp + pp) * 128 + c0) = w; } }
    }
};
struct EpiPool {
    static constexpr bool PERM = true, AFTER_DRAIN = false, MID = false;
    bf16_t* XAB; const bf16_t* GB; int ldg; const float* scale;
    __device__ __forceinline__ void operator()(const f32x4 (&acc)[2][2][4][2], const Unit& u, int wr, int wc, int fr, int fq) const {
        const int row0 = u.pm * BM + wr * 64 + fr; const int col0 = u.pn * BM + wc * 32 + 8 * fq;
        f32x4 sc[2][2];
#pragma unroll
        for (int bj = 0; bj < 2; ++bj)
#pragma unroll
            for (int n = 0; n < 2; ++n) sc[bj][n] = *(const f32x4*)(scale + col0 + bj * HALF + 4 * n);
#pragma unroll
        for (int ai = 0; ai < 2; ++ai)
#pragma unroll
            for (int m = 0; m < 4; ++m) { const size_t row = (size_t)(row0 + ai * HALF + m * 16);
#pragma unroll
                for (int bj = 0; bj < 2; ++bj) { const u32x4 g = *(const u32x4*)(GB + row * ldg + col0 + bj * HALF);
                    const f32x4 v0 = acc[ai][bj][m][0] * sc[bj][0], v1 = acc[ai][bj][m][1] * sc[bj][1];
                    u32x4 w; w.x = cvt_pk_bf16(v0[0] * bflo(g.x), v0[1] * bfhi(g.x)); w.y = cvt_pk_bf16(v0[2] * bflo(g.y), v0[3] * bfhi(g.y));
                    w.z = cvt_pk_bf16(v1[0] * bflo(g.z), v1[1] * bfhi(g.z)); w.w = cvt_pk_bf16(v1[2] * bflo(g.w), v1[3] * bfhi(g.w));
                    *(u32x4*)(XAB + row * 4096 + col0 + bj * HALF) = w; } }
    }
};
struct EpiT1 {
    static constexpr bool PERM = false, AFTER_DRAIN = false, MID = false;
    float* T1; const bf16_t* MA; int ldg;
    __device__ __forceinline__ void operator()(const f32x4 (&acc)[2][2][4][2], const Unit& u, int wr, int wc, int fr, int fq) const {
        const int row0 = u.pm * BM + wr * 64 + fr, col0 = u.pn * BM + wc * 32 + 4 * fq;
#pragma unroll
        for (int ai = 0; ai < 2; ++ai)
#pragma unroll
            for (int m = 0; m < 4; ++m) { const size_t row = (size_t)(row0 + ai * HALF + m * 16);
#pragma unroll
                for (int bj = 0; bj < 2; ++bj)
#pragma unroll
                    for (int n = 0; n < 2; ++n) { const int c = col0 + bj * HALF + n * 16; const u32x2 g = *(const u32x2*)(MA + row * ldg + c);
                        f32x4 v = acc[ai][bj][m][n]; v[0] *= bflo(g.x); v[1] *= bfhi(g.x); v[2] *= bflo(g.y); v[3] *= bfhi(g.y);
                        *(f32x4*)(T1 + row * 4096 + c) = v; } }
    }
};
struct EpiMerge {
    static constexpr bool PERM = false, AFTER_DRAIN = false, MID = false;
    const float* T1; const bf16_t* MB; int ldg; bf16_t* MG;
    __device__ __forceinline__ void operator()(const f32x4 (&acc)[2][2][4][2], const Unit& u, int wr, int wc, int fr, int fq) const {
        const int row0 = u.pm * BM + wr * 64 + fr, col0 = u.pn * BM + wc * 32 + 4 * fq;
#pragma unroll
        for (int ai = 0; ai < 2; ++ai)
#pragma unroll
            for (int m = 0; m < 4; ++m) { const size_t row = (size_t)(row0 + ai * HALF + m * 16);
#pragma unroll
                for (int bj = 0; bj < 2; ++bj)
#pragma unroll
                    for (int n = 0; n < 2; ++n) { const int c = col0 + bj * HALF + n * 16; const u32x2 g = *(const u32x2*)(MB + row * ldg + c); const f32x4 t = *(const f32x4*)(T1 + row * 4096 + c);
                        const f32x4 a = acc[ai][bj][m][n]; u32x2 w; w.x = cvt_pk_bf16(t[0] + a[0] * bflo(g.x), t[1] + a[1] * bfhi(g.x)); w.y = cvt_pk_bf16(t[2] + a[2] * bflo(g.y), t[3] + a[3] * bfhi(g.y));
                        *(u32x2*)(MG + row * 4096 + c) = w; } }
    }
};
struct EpiBranch {
    static constexpr bool PERM = true, AFTER_DRAIN = false, MID = true;
    bf16_t* MG; const bf16_t* MA; const bf16_t* MB; int ldg;
    __device__ __forceinline__ void mid(f32x4 (&acc)[2][2][4][2], const Unit& u, int wr, int wc, int fr, int fq) const {
        asm volatile("" : "+v"(fr), "+v"(fq));
        const int row0 = u.pm * BM + wr * 64 + fr; const int col0 = u.pn * BM + wc * 32 + 8 * fq;
#pragma unroll
        for (int ai = 0; ai < 2; ++ai)
#pragma unroll
            for (int m = 0; m < 4; ++m) { const unsigned go = ((unsigned)(row0 + ai * HALF + m * 16) * (unsigned)ldg + (unsigned)col0) * 2u;
#pragma unroll
                for (int bj = 0; bj < 2; ++bj) { const u32x4 a = *(const u32x4*)((const char*)MA + go + bj * (HALF * 2)), b = *(const u32x4*)((const char*)MB + go + bj * (HALF * 2));
                    f32x4 r0, r1;
                    r0[0] = bflo(a.x) * __builtin_amdgcn_rcpf(bflo(b.x)); r0[1] = bfhi(a.x) * __builtin_amdgcn_rcpf(bfhi(b.x)); r0[2] = bflo(a.y) * __builtin_amdgcn_rcpf(bflo(b.y)); r0[3] = bfhi(a.y) * __builtin_amdgcn_rcpf(bfhi(b.y));
                    r1[0] = bflo(a.z) * __builtin_amdgcn_rcpf(bflo(b.z)); r1[1] = bfhi(a.z) * __builtin_amdgcn_rcpf(bfhi(b.z)); r1[2] = bflo(a.w) * __builtin_amdgcn_rcpf(bflo(b.w)); r1[3] = bfhi(a.w) * __builtin_amdgcn_rcpf(bfhi(b.w));
                    acc[ai][bj][m][0] *= r0; acc[ai][bj][m][1] *= r1; }
                if (m & 1) asm volatile("" : "+v"(acc[ai][0][m - 1][0]), "+v"(acc[ai][0][m - 1][1]), "+v"(acc[ai][1][m - 1][0]), "+v"(acc[ai][1][m - 1][1]), "+v"(acc[ai][0][m][0]), "+v"(acc[ai][0][m][1]), "+v"(acc[ai][1][m][0]), "+v"(acc[ai][1][m][1]) :: "memory"); }
    }
    __device__ __forceinline__ void operator()(const f32x4 (&acc)[2][2][4][2], const Unit& u, int wr, int wc, int fr, int fq) const {
        const int row0 = u.pm * BM + wr * 64 + fr; const int col0 = u.pn * BM + wc * 32 + 8 * fq;
#pragma unroll
        for (int ai = 0; ai < 2; ++ai)
#pragma unroll
            for (int m = 0; m < 4; ++m) { const size_t row = (size_t)(row0 + ai * HALF + m * 16);
#pragma unroll
                for (int bj = 0; bj < 2; ++bj) { const u32x4 b = *(const u32x4*)(MB + row * ldg + col0 + bj * HALF); const f32x4 v0 = acc[ai][bj][m][0], v1 = acc[ai][bj][m][1];
                    u32x4 w; w.x = cvt_pk_bf16(v0[0] * bflo(b.x), v0[1] * bfhi(b.x)); w.y = cvt_pk_bf16(v0[2] * bflo(b.y), v0[3] * bfhi(b.y));
                    w.z = cvt_pk_bf16(v1[0] * bflo(b.z), v1[1] * bfhi(b.z)); w.w = cvt_pk_bf16(v1[2] * bflo(b.w), v1[3] * bfhi(b.w));
                    *(u32x4*)(MG + row * 4096 + col0 + bj * HALF) = w; } }
    }
};
struct EpiRes {
    static constexpr bool PERM = false, AFTER_DRAIN = false, MID = false;
    float* H; float* OUT; bf16_t* HG; const float* gnext; float* SSN;
    __device__ __forceinline__ void operator()(const f32x4 (&acc)[2][2][4][2], const Unit& u, int wr, int wc, int fr, int fq) const {
        const int row0 = u.pm * BM + wr * 64 + fr, col0 = u.pn * BM + wc * 32 + 4 * fq;
        if (OUT) {
#pragma unroll
            for (int ai = 0; ai < 2; ++ai)
#pragma unroll
                for (int m = 0; m < 4; ++m) { const size_t off = (size_t)(row0 + ai * HALF + m * 16) * 4096 + col0;
#pragma unroll
                    for (int bj = 0; bj < 2; ++bj)
#pragma unroll
                        for (int n = 0; n < 2; ++n) { const int c = bj * HALF + n * 16; *(f32x4*)(OUT + off + c) = *(const f32x4*)(H + off + c) + acc[ai][bj][m][n]; } }
        } else {
            f32x4 g[2][2];
#pragma unroll
            for (int bj = 0; bj < 2; ++bj)
#pragma unroll
                for (int n = 0; n < 2; ++n) g[bj][n] = *(const f32x4*)(gnext + col0 + bj * HALF + n * 16);
#pragma unroll
            for (int ai = 0; ai < 2; ++ai)
#pragma unroll
                for (int m = 0; m < 4; ++m) { const int row = row0 + ai * HALF + m * 16; const size_t off = (size_t)row * 4096 + col0; float ssum = 0.f;
#pragma unroll
                    for (int bj = 0; bj < 2; ++bj)
#pragma unroll
                        for (int n = 0; n < 2; ++n) { const int c = bj * HALF + n * 16; const f32x4 h = *(const f32x4*)(H + off + c) + acc[ai][bj][m][n];
                            *(f32x4*)(H + off + c) = h; ssum += (h[0] * h[0] + h[1] * h[1]) + (h[2] * h[2] + h[3] * h[3]);
                            u32x2 w; w.x = cvt_pk_bf16(h[0] * g[bj][n][0], h[1] * g[bj][n][1]); w.y = cvt_pk_bf16(h[2] * g[bj][n][2], h[3] * g[bj][n][3]); *(u32x2*)(HG + off + c) = w; }
                    ssum += __shfl_xor(ssum, 16); ssum += __shfl_xor(ssum, 32);
                    if (fq == 0) atomicAdd(SSN + row, ssum); }
        }
    }
};
struct PoolOrder : StaticOrder {
    __host__ __device__ bool next(int i, Unit& u) const { if (!StaticOrder::next(i, u)) return false; u.aoff = (unsigned)(u.pn >> 1) * 1024u; return true; }
};

template <class Epi, class Sched, bool ALIGN_EPI = false, bool SP2 = false>
__device__ __forceinline__ void gemm_phase(PG8_LAS unsigned char* lds, const Gemm g, const Sched& S, const Epi& E) {
    int tid = threadIdx.x; asm volatile("" : "+v"(tid));
    const int wid = __builtin_amdgcn_readfirstlane(tid >> 6), lane = tid & 63, wr = wid >> 2, wc = wid & 3, fr = lane & 15, fq = lane >> 4;
    const int K = g.K, nt = K / BK;
    unsigned voffA[2], voffB[2];
#pragma unroll
    for (int i = 0; i < 2; ++i) { int R, C; stage_rc(tid * 16 + i * 8192, R, C); const int Rb = Epi::PERM ? ((R & ~31) + perm32(R & 31)) : R;
        voffA[i] = (unsigned)(R * g.lda + C) * 2u; voffB[i] = (unsigned)(Rb * g.ldb + C) * 2u; }
    const size_t kstep = (size_t)(BK * 2);
    const size_t hstepA = (size_t)HALF * g.lda * 2, hstepB = (size_t)HALF * g.ldb * 2;
    const size_t tstepA = 2 * hstepA, tstepB = 2 * hstepB;
    const unsigned ldsw = (unsigned)wid * 1024u;
    const int aoff = lds_byte(wr * 64 + fr, fq * 8), boff = lds_byte(wc * 32 + fr, fq * 8);
#define PG8_SA(b, h) (((b) * 2 + (h)) * HTB)
#define PG8_SB(b, h) ((4 + (b) * 2 + (h)) * HTB)
#define PG8_STAGE(bufoff, gbase, voff) do { _Pragma("unroll") for (int _i = 0; _i < 2; ++_i) \
        __builtin_amdgcn_global_load_lds((const unsigned*)((const char*)(gbase) + (voff)[_i]), (PG8_LAS unsigned*)(lds + (bufoff) + ldsw + _i * 8192), 16, 0, 0); } while (0)
#define PG8_LDA(dst, b, h) do { _Pragma("unroll") for (int m = 0; m < 4; ++m) _Pragma("unroll") for (int k = 0; k < 2; ++k) dst[m][k] = *(const PG8_LAS bf16x8*)(lds + PG8_SA(b, h) + aoff + m * 2048 + k * 1024); } while (0)
#define PG8_LDB(dst, b, h) do { _Pragma("unroll") for (int n = 0; n < 2; ++n) _Pragma("unroll") for (int k = 0; k < 2; ++k) dst[n][k] = *(const PG8_LAS bf16x8*)(lds + PG8_SB(b, h) + boff + n * 2048 + k * 1024); } while (0)
#define PG8_MMA(ai, bj, At, Bt) do { __builtin_amdgcn_s_setprio(1); _Pragma("unroll") for (int m = 0; m < 4; ++m) _Pragma("unroll") for (int n = 0; n < 2; ++n) _Pragma("unroll") for (int k = 0; k < 2; ++k) \
        acc[ai][bj][m][n] = __builtin_amdgcn_mfma_f32_16x16x32_bf16(Bt[n][k], At[m][k], acc[ai][bj][m][n], 0, 0, 0); __builtin_amdgcn_s_setprio(0); } while (0)
#define PG8_WAIT_V(n) asm volatile("s_waitcnt vmcnt(" #n ")" ::: "memory")
#define PG8_WAIT_L(n) asm volatile("s_waitcnt lgkmcnt(" #n ")" ::: "memory")
#define PG8_BAR __builtin_amdgcn_s_barrier()
#define PG8_SCHED __builtin_amdgcn_sched_barrier(0)
    Unit cur, nxt; int ui = 0;
    if (!S.next(0, cur)) return;
    f32x4 acc[2][2][4][2];
#pragma unroll
    for (int a = 0; a < 2; ++a)
#pragma unroll
        for (int b = 0; b < 2; ++b)
#pragma unroll
            for (int m = 0; m < 4; ++m)
#pragma unroll
                for (int n = 0; n < 2; ++n) acc[a][b][m][n] = (f32x4){0.f, 0.f, 0.f, 0.f};
    bf16x8 At[4][2], B0[2][2], B1[2][2];
    const char* cA = (const char*)g.A + (size_t)cur.pm * tstepA + cur.aoff; const char* cB = (const char*)g.Bt + (size_t)cur.pn * tstepB;
    S.a_ready(cur);
    if constexpr (SP2) {
        PG8_STAGE(PG8_SB(0, 0), cB, voffB); PG8_STAGE(PG8_SB(0, 1), cB + hstepB, voffB); PG8_STAGE(PG8_SA(0, 0), cA, voffA); PG8_STAGE(PG8_SA(0, 1), cA + hstepA, voffA);
        if (wr == 1) PG8_BAR;
        PG8_WAIT_V(2); PG8_BAR;
        PG8_STAGE(PG8_SB(1, 0), cB + kstep, voffB); PG8_STAGE(PG8_SA(1, 0), cA + kstep, voffA); PG8_STAGE(PG8_SB(1, 1), cB + hstepB + kstep, voffB);
        PG8_WAIT_V(6); PG8_BAR;
    } else {
        PG8_STAGE(PG8_SB(0, 0), cB, voffB); PG8_STAGE(PG8_SA(0, 0), cA, voffA); PG8_STAGE(PG8_SB(0, 1), cB + hstepB, voffB); PG8_STAGE(PG8_SA(0, 1), cA + hstepA, voffA);
        if (wr == 1) PG8_BAR;
        PG8_WAIT_V(4); PG8_BAR;
        PG8_STAGE(PG8_SB(1, 0), cB + kstep, voffB); PG8_STAGE(PG8_SA(1, 0), cA + kstep, voffA); PG8_STAGE(PG8_SB(1, 1), cB + hstepB + kstep, voffB);
        PG8_WAIT_V(6); PG8_BAR;
    }
    for (;;) {
        const bool has_next = S.next(ui + 1, nxt);
        const char* nA = has_next ? (const char*)g.A + (size_t)nxt.pm * tstepA + nxt.aoff : cA; const char* nB = has_next ? (const char*)g.Bt + (size_t)nxt.pn * tstepB : cB;
        for (int t = 0; t < nt; t += 2) {
            const bool last = (t == nt - 2);
            if constexpr (Epi::MID) { if (t == (nt >> 1)) E.mid(acc, cur, wr, wc, fr, fq); }
            const char* a1 = cA + (size_t)(t + 1) * kstep;
            const char* a2 = last ? nA : cA + (size_t)(t + 2) * kstep; const char* b2 = last ? nB : cB + (size_t)(t + 2) * kstep;
            const char* a3 = a2 + kstep; const char* b3 = b2 + kstep;
            if (last && has_next) S.a_ready(nxt);
            if constexpr (SP2) {
            PG8_LDB(B0, 0, 0); PG8_LDB(B1, 0, 1); PG8_SCHED; PG8_LDA(At, 0, 0); PG8_STAGE(PG8_SA(1, 1), a1 + hstepA, voffA);
            PG8_WAIT_V(8); PG8_WAIT_L(0); PG8_BAR; PG8_MMA(0, 0, At, B0); PG8_MMA(0, 1, At, B1); PG8_BAR; PG8_SCHED;
            PG8_LDA(At, 0, 1); PG8_STAGE(PG8_SB(0, 0), b2, voffB); PG8_STAGE(PG8_SB(0, 1), b2 + hstepB, voffB); PG8_STAGE(PG8_SA(0, 0), a2, voffA);
            PG8_WAIT_V(8); PG8_WAIT_L(0); PG8_BAR; PG8_MMA(1, 0, At, B0); PG8_MMA(1, 1, At, B1); PG8_BAR; PG8_SCHED;
            PG8_LDB(B0, 1, 0); PG8_LDB(B1, 1, 1); PG8_SCHED; PG8_LDA(At, 1, 0); PG8_STAGE(PG8_SA(0, 1), a2 + hstepA, voffA);
            PG8_WAIT_V(8); PG8_WAIT_L(0); PG8_BAR; PG8_MMA(0, 0, At, B0); PG8_MMA(0, 1, At, B1); PG8_BAR; PG8_SCHED;
            PG8_LDA(At, 1, 1); PG8_STAGE(PG8_SB(1, 0), b3, voffB); PG8_STAGE(PG8_SB(1, 1), b3 + hstepB, voffB); PG8_STAGE(PG8_SA(1, 0), a3, voffA);
            PG8_WAIT_V(8); PG8_WAIT_L(0); PG8_BAR; PG8_MMA(1, 0, At, B0); PG8_MMA(1, 1, At, B1); PG8_BAR; PG8_SCHED;
            } else {
            PG8_LDB(B0, 0, 0); PG8_SCHED; PG8_LDA(At, 0, 0); PG8_STAGE(PG8_SA(1, 1), a1 + hstepA, voffA);
            PG8_WAIT_L(8); PG8_BAR; PG8_WAIT_L(0); PG8_MMA(0, 0, At, B0); PG8_BAR; PG8_SCHED;
            PG8_LDB(B1, 0, 1); PG8_STAGE(PG8_SB(0, 0), b2, voffB);
            PG8_BAR; PG8_WAIT_L(0); PG8_MMA(0, 1, At, B1); PG8_BAR;
            PG8_LDA(At, 0, 1); PG8_STAGE(PG8_SA(0, 0), a2, voffA);
            PG8_BAR; PG8_WAIT_L(0); PG8_MMA(1, 0, At, B0); PG8_BAR; PG8_SCHED;
            PG8_STAGE(PG8_SB(0, 1), b2 + hstepB, voffB);
            PG8_WAIT_V(6); PG8_BAR; PG8_MMA(1, 1, At, B1); PG8_BAR;
            PG8_LDB(B0, 1, 0); PG8_SCHED; PG8_LDA(At, 1, 0); PG8_STAGE(PG8_SA(0, 1), a2 + hstepA, voffA);
            PG8_WAIT_L(8); PG8_BAR; PG8_WAIT_L(0); PG8_MMA(0, 0, At, B0); PG8_BAR; PG8_SCHED;
            PG8_LDB(B1, 1, 1); PG8_STAGE(PG8_SB(1, 0), b3, voffB);
            PG8_BAR; PG8_WAIT_L(0); PG8_MMA(0, 1, At, B1); PG8_BAR;
            PG8_LDA(At, 1, 1); PG8_STAGE(PG8_SA(1, 0), a3, voffA);
            PG8_BAR; PG8_WAIT_L(0); PG8_MMA(1, 0, At, B0); PG8_BAR; PG8_SCHED;
            PG8_STAGE(PG8_SB(1, 1), b3 + hstepB, voffB);
            PG8_WAIT_V(6); PG8_BAR; PG8_MMA(1, 1, At, B1); PG8_BAR;
            }
        }
        if constexpr (ALIGN_EPI) { if (wr == 0) PG8_BAR; }
        if constexpr (!Epi::AFTER_DRAIN) { E(acc, cur, wr, wc, fr, fq); S.done(cur); }
        if (!has_next) break;
#pragma unroll
        for (int a = 0; a < 2; ++a)
#pragma unroll
            for (int b = 0; b < 2; ++b)
#pragma unroll
                for (int m = 0; m < 4; ++m)
#pragma unroll
                    for (int n = 0; n < 2; ++n) acc[a][b][m][n] = (f32x4){0.f, 0.f, 0.f, 0.f};
        cur = nxt; cA = nA; cB = nB; ++ui;
        if constexpr (ALIGN_EPI) { if (wr == 1) PG8_BAR; }
    }
    PG8_WAIT_V(0);
    if constexpr (!ALIGN_EPI) { if (wr == 0) PG8_BAR; }
    PG8_BAR;
    if constexpr (Epi::AFTER_DRAIN) { E.fused(acc, cur, wr, wc, fr, fq, lds, wid, lane); S.done(cur); }
#undef PG8_SA
#undef PG8_SB
#undef PG8_STAGE
#undef PG8_LDA
#undef PG8_LDB
#undef PG8_MMA
#undef PG8_WAIT_V
#undef PG8_WAIT_L
#undef PG8_BAR
#undef PG8_SCHED
}
}
#ifndef DBLMASK
#define DBLMASK 0
#endif
#ifndef PG8_SP2
#define PG8_SP2 true
#endif
#ifndef PG8_ALIGN
#define PG8_ALIGN true
#endif

constexpr int NWAVES = 8;
constexpr int D_MODEL = 4096, BATCH = 4, SEQ = 4096, DEPTH = 4, N_META = 16, LSEQ = N_META + SEQ  ;
constexpr int MMAIN = BATCH * SEQ  , NMETA_ROWS = BATCH * N_META  , MP = MMAIN + NMETA_ROWS  ;
constexpr int HEADS = 16, NOPE = 128, ROPE = 64, QKD = 192, VD = 128, MLAW = 2048, QLORA = 1024, KVLORA = 512, POOLW = 2048;
constexpr int IN_WIDTH = 15936, NIN = 16128;
constexpr int PC_CQ = 0, PC_CKV = 1024, PC_U = 1536, PC_GA = 3584, PC_GB = 5632, PC_MA = 7680, PC_MB = 11776, PC_KR = 15872;
constexpr int LP = 4160;
constexpr float NORM_EPS = 1e-6f;

constexpr size_t al256(size_t x) { return (x + 255) / 256 * 256; }
constexpr size_t WS_CTL = 0, CTL_ZERO_BYTES = 1u << 20;
constexpr size_t WS_TAB = CTL_ZERO_BYTES;
constexpr size_t WS_W = WS_TAB + al256((size_t)LSEQ * 32 * 8);
constexpr size_t WL_IN = 0, WL_UQ = WL_IN + (size_t)NIN * 4096 * 2, WL_UKV = WL_UQ + (size_t)3072 * 1024 * 2, WL_POOL = WL_UKV + (size_t)4096 * 512 * 2,
                 WL_AB = WL_POOL + (size_t)2048 * 512 * 2, WL_OUT = WL_AB + (size_t)4096 * 4096 * 2, WL_SIZE = WL_OUT + (size_t)4096 * 4096 * 2;
constexpr size_t WS_SS = WS_W + DEPTH * WL_SIZE;
constexpr size_t WS_H = WS_SS + al256((size_t)2 * MP * 4);
constexpr size_t WS_HN = WS_H + (size_t)MP * 4096 * 4;
constexpr size_t WS_PROJ = WS_HN + (size_t)MP * 4096 * 2;
constexpr size_t WS_CQN = WS_PROJ + (size_t)MP * NIN * 2;
constexpr size_t WS_CKVN = WS_CQN + (size_t)MP * 1024 * 2;
constexpr size_t WS_DIFF = WS_CKVN + (size_t)MP * 512 * 2;
constexpr size_t WS_QRAW = WS_DIFF + (size_t)MP * 2048 * 2;
constexpr size_t WS_KRAW = WS_QRAW + (size_t)MP * 3072 * 2;
constexpr size_t WS_QA = WS_KRAW + (size_t)MP * 2048 * 2;
constexpr size_t WS_KA = WS_QA + (size_t)64 * LP * 192 * 2;
constexpr size_t WS_VA = WS_KA + (size_t)64 * LP * 192 * 2;
constexpr size_t WS_XAB = WS_VA + (size_t)64 * LP * 128 * 2;
constexpr size_t WS_T1 = WS_XAB + (size_t)MP * 4096 * 2;
constexpr size_t WS_MG = WS_T1 + (size_t)MP * 4096 * 4;
constexpr size_t WS_END = WS_MG + (size_t)MP * 4096 * 2 + 65536;
constexpr int CW_TMO = 0, CW_BAR = 4096;

constexpr int RING_OFF = 0, RING_BYTES = 131072, LDSCTL_OFF = RING_BYTES, MISC_OFF = LDSCTL_OFF + 320, LDS_BYTES = 147456;

#define GAS __attribute__((address_space(1)))
#define LAS __attribute__((address_space(3)))
typedef unsigned short bf16;
typedef unsigned v4u __attribute__((ext_vector_type(4)));
typedef unsigned v2u __attribute__((ext_vector_type(2)));
typedef float f32x4 __attribute__((ext_vector_type(4)));
typedef short bf16x8 __attribute__((ext_vector_type(8)));
typedef short s16x4 __attribute__((ext_vector_type(4)));
typedef float f32x16 __attribute__((ext_vector_type(16)));
#define LDS_WAIT() asm volatile("s_waitcnt lgkmcnt(0)" ::: "memory")
#define VM_WAIT() asm volatile("s_waitcnt vmcnt(0)" ::: "memory")
#define WG_BAR() do { asm volatile("s_waitcnt lgkmcnt(0)" ::: "memory"); __builtin_amdgcn_s_barrier(); asm volatile("" ::: "memory"); } while (0)
__device__ __forceinline__ unsigned cvtpk(float lo, float hi) { unsigned r; asm volatile("v_cvt_pk_bf16_f32 %0, %1, %2" : "=v"(r) : "v"(lo), "v"(hi)); return r; }
__device__ __forceinline__ float bflo(unsigned u) { return __uint_as_float(u << 16); }
__device__ __forceinline__ float bfhi(unsigned u) { return __uint_as_float(u & 0xffff0000u); }
__device__ __forceinline__ float wave_sum(float v) {
#pragma unroll
    for (int o = 1; o < 64; o <<= 1) v += __shfl_xor(v, o);
    return v;
}

__device__ __forceinline__ void row_bp(int m, int& b, int& pos) { if (m < MMAIN) { b = m >> 12; pos = N_META + (m & 4095); } else { const int j = m - MMAIN; b = j >> 4; pos = j & 15; } }
__device__ __forceinline__ int row_of(int b, int pos) { return pos >= N_META ? b * SEQ + pos - N_META : MMAIN + b * N_META + pos; }

#define XB_TMO      128
#define XB_XCNT(j)  (256  + 64 * (j))
#define XB_XSUB(j)  (1280 + 64 * (j))
#define XB_XGEN(j)  (2304 + 64 * (j))
#define XB_TOP      3328
#define XB_TOPGEN   3392
#define XCD_BAR_WORDS 3456
#define XB_SPIN_CAP (1u << 18)
__device__ __forceinline__ unsigned xb_ld(unsigned* p)              { return __hip_atomic_load(p, __ATOMIC_RELAXED, __HIP_MEMORY_SCOPE_AGENT); }
__device__ __forceinline__ unsigned xb_add(unsigned* p, unsigned v) { return __hip_atomic_fetch_add(p, v, __ATOMIC_RELAXED, __HIP_MEMORY_SCOPE_AGENT); }
__device__ __forceinline__ unsigned xb_xcc_id() { return (unsigned)__builtin_amdgcn_s_getreg((3 << 11) | 20) & 0xFu; }
#define XB_SPIN(cond, bar) do { unsigned _sp = 0; while (cond) { __builtin_amdgcn_s_sleep(1); \
    if ((++_sp & 255u) == 0u) { if (xb_ld(&(bar)[XB_TMO])) break; if (_sp > XB_SPIN_CAP) { atomicAdd(&(bar)[XB_TMO], 1u); break; } } } } while (0)
struct XcdBarrier { unsigned* bar; unsigned x; volatile LAS unsigned* st; };
__device__ __forceinline__ XcdBarrier xcd_barrier_post(unsigned* bar, volatile LAS unsigned* st) {
    XcdBarrier b; b.bar = bar; b.x = xb_xcc_id(); b.st = st;
    if (threadIdx.x == 0) (void)xb_add(&bar[XB_XCNT(b.x)], 1u);
    return b;
}
__device__ __forceinline__ void xcd_barrier_complete(unsigned* bar, unsigned x, unsigned& nloc, unsigned& nx) {
    const unsigned G = gridDim.x * gridDim.y * gridDim.z;
    unsigned sum, cnt, mine, sp = 0u;
    for (;;) {
        sum = 0u; cnt = 0u; mine = 0u;
#pragma unroll
        for (unsigned j = 0; j < 16; ++j) { const unsigned c = xb_ld(&bar[XB_XCNT(j)]); sum += c; cnt += (c > 0u) ? 1u : 0u; mine = (j == x) ? c : mine; }
        if (sum == G) break;
        __builtin_amdgcn_s_sleep(1);
        if ((++sp & 255u) == 0u) { if (xb_ld(&bar[XB_TMO])) break; if (sp > XB_SPIN_CAP) { atomicAdd(&bar[XB_TMO], 1u); break; } }
    }
    nloc = mine > 0u ? mine : 1u; nx = cnt > 0u ? cnt : 1u;
}
__device__ __forceinline__ void xcd_barrier(const XcdBarrier& b) {
    asm volatile("s_waitcnt vmcnt(0)" ::: "memory");
    __syncthreads();
    if (threadIdx.x == 0) {
        unsigned* bar = b.bar;
        __builtin_amdgcn_s_waitcnt(0);
        unsigned nloc = b.st[0], nx = b.st[1];
        if (nloc == 0u) { xcd_barrier_complete(bar, b.x, nloc, nx); b.st[0] = nloc; b.st[1] = nx; }
        const unsigned old = xb_add(&bar[XB_XSUB(b.x)], 1u);
        const unsigned gen = old / nloc;
        if (old + 1u == (gen + 1u) * nloc) {
            __builtin_amdgcn_fence(__ATOMIC_RELEASE, "agent");
            asm volatile("s_waitcnt vmcnt(0)" ::: "memory");
            const unsigned og = xb_add(&bar[XB_TOP], 1u);
            const unsigned tg = og / nx;
            if (og + 1u == (tg + 1u) * nx) xb_add(&bar[XB_TOPGEN], 1u);
            else XB_SPIN(xb_ld(&bar[XB_TOPGEN]) == tg, bar);
            __builtin_amdgcn_fence(__ATOMIC_ACQUIRE, "agent");
            xb_add(&bar[XB_XGEN(b.x)], 1u);
            asm volatile("s_waitcnt vmcnt(0)" ::: "memory");
        } else {
            XB_SPIN(xb_ld(&bar[XB_XGEN(b.x)]) == gen, bar);
            __builtin_amdgcn_fence(__ATOMIC_ACQUIRE, "agent");
            asm volatile("s_waitcnt vmcnt(0)" ::: "memory");
        }
    }
    __syncthreads();
}

struct Frame {
    LAS unsigned char* lds;
    int tid, lane, wave, vcu, G;
    unsigned char* ws;
    const float* in[15];
    float* out;
};
enum { I_X = 0, I_META, I_NORMG, I_WIN, I_QLG, I_KVLG, I_WUQ, I_WUKV, I_QHG, I_KHG, I_WPOOL, I_PSCALE, I_WA, I_WB, I_WOUT };

__device__ __forceinline__ void tr_item(const float* W, int ldw, int k0, int nsrc0, bf16* WT, int ldt, int ndst0, int kdst0, LAS float* scr, int lane) {
#pragma unroll 8
    for (int i = 0; i < 32; ++i) { const int kk = 2 * i + (lane >> 5); scr[kk * 33 + (lane & 31)] = W[(size_t)(k0 + kk) * ldw + nsrc0 + (lane & 31)]; }
    LDS_WAIT(); asm volatile("" ::: "memory");
    const int c = lane & 7;
#pragma unroll
    for (int j = 0; j < 4; ++j) { const int n = (lane >> 3) + 8 * j; const LAS float* s = scr + (8 * c) * 33 + n;
        v4u o; o.x = cvtpk(s[0 * 33], s[1 * 33]); o.y = cvtpk(s[2 * 33], s[3 * 33]); o.z = cvtpk(s[4 * 33], s[5 * 33]); o.w = cvtpk(s[6 * 33], s[7 * 33]);
        *(GAS v4u*)(WT + (size_t)(ndst0 + n) * ldt + kdst0 + k0 + 8 * c) = o; }
    LDS_WAIT(); asm volatile("" ::: "memory");
}
constexpr int IT_IN = 64 * (NIN / 32), IT_UQ = 16 * 96, IT_UKV = 8 * 128, IT_POOL = 4 * 8 * 16, IT_A = 32 * 128, IT_B = 32 * 128, IT_OUT = 64 * 128;
constexpr int IT_LAYER = IT_IN + IT_UQ + IT_UKV + IT_POOL + IT_A + IT_B + IT_OUT;
__device__ __forceinline__ void p0_prologue(Frame& F0) {
    struct { LAS unsigned char* lds; int tid, lane, wave, vcu, G; unsigned char* ws; const float* const* in; } F;
    F.lds = F0.lds; F.tid = F0.tid; asm volatile("" : "+v"(F.tid)); F.lane = F.tid & 63; F.wave = F0.wave; F.vcu = F0.vcu; F.G = F0.G; F.ws = F0.ws; F.in = F0.in;
    LAS float* scr = (LAS float*)(F.lds + RING_OFF + F.wave * 16384);
    const int gw = F.vcu * NWAVES + F.wave, NGW = F.G * NWAVES;
    for (int it = gw; it < DEPTH * IT_LAYER; it += NGW) {
        const int l = it / IT_LAYER; int r = it - l * IT_LAYER;
        bf16* wl = (bf16*)(F.ws + WS_W + (size_t)l * WL_SIZE);
        if (r < IT_IN) { const int kb = r / (NIN / 32), nb = r - kb * (NIN / 32), nd = nb * 32, k0 = kb * 64;
            bf16* WT = (bf16*)((unsigned char*)wl + WL_IN);
            if (nd >= IN_WIDTH) {
#pragma unroll
                for (int j = 0; j < 4; ++j) { const int q = j * 64 + F.lane, n = q >> 3, c = q & 7; *(GAS v4u*)(WT + (size_t)(nd + n) * 4096 + k0 + 8 * c) = (v4u){0u, 0u, 0u, 0u}; }
            } else { const int ns = nd < 1536 ? nd : (nd < PC_KR ? nd + 64 : nd - PC_KR + 1536);
                tr_item(F.in[I_WIN] + (size_t)l * 4096 * IN_WIDTH, IN_WIDTH, k0, ns, WT, 4096, nd, 0, scr, F.lane); }
            continue; }
        r -= IT_IN;
        if (r < IT_UQ) { const int kb = r / 96, nb = r - kb * 96; tr_item(F.in[I_WUQ] + (size_t)l * 1024 * 3072, 3072, kb * 64, nb * 32, (bf16*)((unsigned char*)wl + WL_UQ), 1024, nb * 32, 0, scr, F.lane); continue; }
        r -= IT_UQ;
        if (r < IT_UKV) { const int kb = r / 128, nb = r - kb * 128; tr_item(F.in[I_WUKV] + (size_t)l * 512 * 4096, 4096, kb * 64, nb * 32, (bf16*)((unsigned char*)wl + WL_UKV), 512, nb * 32, 0, scr, F.lane); continue; }
        r -= IT_UKV;
        if (r < IT_POOL) { const int g = r / 128, rr = r - g * 128, kb = rr / 16, nb = rr - kb * 16;
            tr_item(F.in[I_WPOOL] + ((size_t)l * 4 + g) * 512 * 512, 512, kb * 64, nb * 32, (bf16*)((unsigned char*)wl + WL_POOL), 512, g * 512 + nb * 32, 0, scr, F.lane); continue; }
        r -= IT_POOL;
        if (r < IT_A) { const int kb = r / 128, nb = r - kb * 128; tr_item(F.in[I_WA] + (size_t)l * 2048 * 4096, 4096, kb * 64, nb * 32, (bf16*)((unsigned char*)wl + WL_AB), 4096, nb * 32, 0, scr, F.lane); continue; }
        r -= IT_A;
        if (r < IT_B) { const int kb = r / 128, nb = r - kb * 128; tr_item(F.in[I_WB] + (size_t)l * 2048 * 4096, 4096, kb * 64, nb * 32, (bf16*)((unsigned char*)wl + WL_AB), 4096, nb * 32, 2048, scr, F.lane); continue; }
        r -= IT_B;
        { const int kb = r / 128, nb = r - kb * 128; tr_item(F.in[I_WOUT] + (size_t)l * 4096 * 4096, 4096, kb * 64, nb * 32, (bf16*)((unsigned char*)wl + WL_OUT), 4096, nb * 32, 0, scr, F.lane); }
    }
    const size_t gt = (size_t)(F.vcu) * (NWAVES * 64) + F.tid, NT = (size_t)F.G * NWAVES * 64;
    { float* H = (float*)(F.ws + WS_H); bf16* HG = (bf16*)(F.ws + WS_HN); float* SS = (float*)(F.ws + WS_SS); const float* g = F.in[I_NORMG];
      for (int m = gw; m < MP; m += NGW) {
          const float* src = m < MMAIN ? F.in[I_X] + (size_t)m * 4096 : F.in[I_META] + (size_t)((m - MMAIN) & 15) * 4096;
          const GAS f32x4* xr = (const GAS f32x4*)src + F.lane; GAS f32x4* hr = (GAS f32x4*)(H + (size_t)m * 4096) + F.lane; GAS v2u* o = (GAS v2u*)(HG + (size_t)m * 4096) + F.lane;
          float ss = 0.f;
#pragma unroll 4
          for (int j = 0; j < 16; ++j) { const f32x4 v = xr[64 * j]; const f32x4 gg = *((const GAS f32x4*)g + F.lane + 64 * j); ss += (v.x * v.x + v.y * v.y) + (v.z * v.z + v.w * v.w);
              hr[64 * j] = v; v2u w; w.x = cvtpk(v.x * gg.x, v.y * gg.y); w.y = cvtpk(v.z * gg.z, v.w * gg.w); o[64 * j] = w; }
          ss = wave_sum(ss); if (F.lane == 0) SS[m] = ss; } }
    { float* TAB = (float*)(F.ws + WS_TAB);
      for (size_t i = gt; i < (size_t)LSEQ * 32; i += NT) { const int pos = (int)(i >> 5), fi = (int)(i & 31);
          const float inv = 1.0f / powf(10000.0f, (float)fi * (1.0f / 32.0f)); const float ang = (float)pos * inv;
          double rev = (double)ang * 0.15915494309189533577; rev -= rint(rev); const float rv = (float)rev;
          TAB[2 * i] = __builtin_amdgcn_cosf(rv); TAB[2 * i + 1] = __builtin_amdgcn_sinf(rv); } }
    { bf16* KA = (bf16*)(F.ws + WS_KA); bf16* VA = (bf16*)(F.ws + WS_VA);
      for (size_t i = gt; i < (size_t)64 * 48 * 24; i += NT) { const int bh = (int)(i / (48 * 24)), rr = (int)(i % (48 * 24)); *(GAS v4u*)(KA + ((size_t)bh * LP + 16) * 192 + rr * 8) = (v4u){0u, 0u, 0u, 0u}; }
      for (size_t i = gt; i < (size_t)64 * 48 * 16; i += NT) { const int bh = (int)(i / (48 * 16)), rr = (int)(i % (48 * 16)); *(GAS v4u*)(VA + ((size_t)bh * LP + 16) * 128 + rr * 8) = (v4u){0u, 0u, 0u, 0u}; } }
}

__device__ __forceinline__ void unpack8(const v4u& u, float (&f)[8]) { f[0] = bflo(u.x); f[1] = bfhi(u.x); f[2] = bflo(u.y); f[3] = bfhi(u.y); f[4] = bflo(u.z); f[5] = bfhi(u.z); f[6] = bflo(u.w); f[7] = bfhi(u.w); }
__device__ __forceinline__ void p3_latent(Frame& F0, const float* qg, const float* kvg, float* ssn) {
    struct { int lane, wave, vcu, G; unsigned char* ws; } F; F.lane = F0.lane; asm volatile("" : "+v"(F.lane)); F.wave = F0.wave; F.vcu = F0.vcu; F.G = F0.G; F.ws = F0.ws;
    const int gw = F.vcu * NWAVES + F.wave, NGW = F.G * NWAVES;
    const bf16* PROJ = (const bf16*)(F.ws + WS_PROJ); bf16* CQN = (bf16*)(F.ws + WS_CQN); bf16* CKVN = (bf16*)(F.ws + WS_CKVN); bf16* DIFF = (bf16*)(F.ws + WS_DIFF);
    for (int m = gw; m < MP; m += NGW) {
        const bf16* pr = PROJ + (size_t)m * NIN;
        if (ssn && F.lane == 0) ssn[m] = 0.f;
        {
            float x[2][8]; float ss = 0.f;
#pragma unroll
            for (int j = 0; j < 2; ++j) { const v4u u = *(const GAS v4u*)(pr + PC_CQ + (j * 64 + F.lane) * 8); unpack8(u, x[j]);
#pragma unroll
                for (int e = 0; e < 8; ++e) ss += x[j][e] * x[j][e]; }
            const float r = 1.0f / sqrtf(wave_sum(ss) * (1.0f / 1024.0f) + NORM_EPS);
#pragma unroll
            for (int j = 0; j < 2; ++j) { const int c = (j * 64 + F.lane) * 8; const f32x4 g0 = *(const GAS f32x4*)(qg + c), g1 = *(const GAS f32x4*)(qg + c + 4);
                v4u w; w.x = cvtpk(x[j][0] * r * g0.x, x[j][1] * r * g0.y); w.y = cvtpk(x[j][2] * r * g0.z, x[j][3] * r * g0.w); w.z = cvtpk(x[j][4] * r * g1.x, x[j][5] * r * g1.y); w.w = cvtpk(x[j][6] * r * g1.z, x[j][7] * r * g1.w);
                *(GAS v4u*)(CQN + (size_t)m * 1024 + c) = w; }
        }
        {
            float x[8]; float ss = 0.f; const int c = F.lane * 8;
            const v4u u = *(const GAS v4u*)(pr + PC_CKV + c); unpack8(u, x);
#pragma unroll
            for (int e = 0; e < 8; ++e) ss += x[e] * x[e];
            const float r = 1.0f / sqrtf(wave_sum(ss) * (1.0f / 512.0f) + NORM_EPS);
            const f32x4 g0 = *(const GAS f32x4*)(kvg + c), g1 = *(const GAS f32x4*)(kvg + c + 4);
            v4u w; w.x = cvtpk(x[0] * r * g0.x, x[1] * r * g0.y); w.y = cvtpk(x[2] * r * g0.z, x[3] * r * g0.w); w.z = cvtpk(x[4] * r * g1.x, x[5] * r * g1.y); w.w = cvtpk(x[6] * r * g1.z, x[7] * r * g1.w);
            *(GAS v4u*)(CKVN + (size_t)m * 512 + c) = w;
        }
        {
            int b, pos; row_bp(m, b, pos);
#pragma unroll
            for (int j = 0; j < 4; ++j) { const int c = (j * 64 + F.lane) * 8; const int w = 2 << j; const int n = pos + 1 < w ? pos + 1 : w;
                float u0[8], acc[8];
                { const v4u u = *(const GAS v4u*)(pr + PC_U + c); unpack8(u, u0); }
#pragma unroll
                for (int e = 0; e < 8; ++e) acc[e] = u0[e];
                for (int i = 1; i < n; ++i) { float t[8]; const v4u u = *(const GAS v4u*)(PROJ + (size_t)row_of(b, pos - i) * NIN + PC_U + c); unpack8(u, t);
#pragma unroll
                    for (int e = 0; e < 8; ++e) acc[e] += t[e]; }
                const float rn = 1.0f / (float)n; float d[8];
#pragma unroll
                for (int e = 0; e < 8; ++e) d[e] = acc[e] * rn - u0[e];
                v4u o; o.x = cvtpk(d[0], d[1]); o.y = cvtpk(d[2], d[3]); o.z = cvtpk(d[4], d[5]); o.w = cvtpk(d[6], d[7]);
                *(GAS v4u*)(DIFF + (size_t)m * 2048 + c) = o; }
        }
    }
}

__device__ __forceinline__ void p5_qknorm(Frame& F0, const float* qhg, const float* khg) {
    struct { int lane, wave, vcu, G; unsigned char* ws; } F; F.lane = F0.lane; asm volatile("" : "+v"(F.lane)); F.wave = F0.wave; F.vcu = F0.vcu; F.G = F0.G; F.ws = F0.ws;
    const int gw = F.vcu * NWAVES + F.wave, NGW = F.G * NWAVES;
    const bf16* PROJ = (const bf16*)(F.ws + WS_PROJ); const bf16* QRAW = (const bf16*)(F.ws + WS_QRAW); const bf16* KRAW = (const bf16*)(F.ws + WS_KRAW);
    bf16* QA = (bf16*)(F.ws + WS_QA); bf16* KA = (bf16*)(F.ws + WS_KA); const float* TAB = (const float*)(F.ws + WS_TAB);
    const int j = F.lane & 31, half = F.lane >> 5;
    float gq[6], gk[6];
#pragma unroll
    for (int t = 0; t < 3; ++t) { gq[2 * t] = qhg[64 * t + 2 * j]; gq[2 * t + 1] = qhg[64 * t + 2 * j + 1]; gk[2 * t] = khg[64 * t + 2 * j]; gk[2 * t + 1] = khg[64 * t + 2 * j + 1]; }
    const int fi = (2 * j) & 31;
    for (int m = gw; m < MP; m += NGW) {
        int b, pos; row_bp(m, b, pos); const int pp = pos < N_META ? pos : pos + 48;
        const f32x4 cs = *(const GAS f32x4*)(TAB + ((size_t)pos * 32 + fi) * 2);
        const unsigned kr = *(const GAS unsigned*)(PROJ + (size_t)m * NIN + PC_KR + 2 * j);
#pragma unroll 2
        for (int it = 0; it < 8; ++it) { const int h = 2 * it + half;
            {
                const bf16* src = QRAW + (size_t)m * 3072 + h * 192 + 2 * j;
                const unsigned u0 = *(const GAS unsigned*)src, u1 = *(const GAS unsigned*)(src + 64), u2 = *(const GAS unsigned*)(src + 128);
                float x[6] = {bflo(u0), bfhi(u0), bflo(u1), bfhi(u1), bflo(u2), bfhi(u2)};
                float ss = 0.f;
#pragma unroll
                for (int e = 0; e < 6; ++e) ss += x[e] * x[e];
#pragma unroll
                for (int o = 1; o < 32; o <<= 1) ss += __shfl_xor(ss, o);
                const float r = 1.0f / sqrtf(ss * (1.0f / 192.0f) + NORM_EPS);
#pragma unroll
                for (int e = 0; e < 6; ++e) x[e] = x[e] * r * gq[e];
                const float p0 = __shfl_xor(x[4], 16), p1 = __shfl_xor(x[5], 16);
                const float y0 = j < 16 ? x[4] * cs.x - p0 * cs.y : x[4] * cs.x + p0 * cs.y;
                const float y1 = j < 16 ? x[5] * cs.z - p1 * cs.w : x[5] * cs.z + p1 * cs.w;
                bf16* dst = QA + ((size_t)(b * 16 + h) * LP + pp) * 192 + 2 * j;
                *(GAS unsigned*)dst = cvtpk(x[0], x[1]); *(GAS unsigned*)(dst + 64) = cvtpk(x[2], x[3]); *(GAS unsigned*)(dst + 128) = cvtpk(y0, y1);
            }
            {
                const bf16* src = KRAW + (size_t)m * 2048 + h * 128 + 2 * j;
                const unsigned u0 = *(const GAS unsigned*)src, u1 = *(const GAS unsigned*)(src + 64);
                float x[6] = {bflo(u0), bfhi(u0), bflo(u1), bfhi(u1), bflo(kr), bfhi(kr)};
                float ss = 0.f;
#pragma unroll
                for (int e = 0; e < 6; ++e) ss += x[e] * x[e];
#pragma unroll
                for (int o = 1; o < 32; o <<= 1) ss += __shfl_xor(ss, o);
                const float r = 1.0f / sqrtf(ss * (1.0f / 192.0f) + NORM_EPS);
#pragma unroll
                for (int e = 0; e < 6; ++e) x[e] = x[e] * r * gk[e];
                const float p0 = __shfl_xor(x[4], 16), p1 = __shfl_xor(x[5], 16);
                const float y0 = j < 16 ? x[4] * cs.x - p0 * cs.y : x[4] * cs.x + p0 * cs.y;
                const float y1 = j < 16 ? x[5] * cs.z - p1 * cs.w : x[5] * cs.z + p1 * cs.w;
                bf16* dst = KA + ((size_t)(b * 16 + h) * LP + pp) * 192 + 2 * j;
                *(GAS unsigned*)dst = cvtpk(x[0], x[1]); *(GAS unsigned*)(dst + 64) = cvtpk(x[2], x[3]); *(GAS unsigned*)(dst + 128) = cvtpk(y0, y1);
            }
        }
    }
}

namespace att {
constexpr int KROW = 400, SHM_K = 64 * KROW, SHM_V = 64 * 128 * 2;
constexpr int OFF_V = 0, OFF_K = 2 * SHM_V, OFF_WS = OFF_K + 2 * SHM_K, ATT_LDS = OFF_WS + NWAVES * 64 * 4;
static_assert(ATT_LDS <= RING_BYTES, "attention LDS");
constexpr float SCALE = 0.07216878364870322f;
__device__ __forceinline__ int crow(int r, int hi) { return (r & 3) + 8 * (r >> 2) + 4 * hi; }
__device__ __forceinline__ int v_st(int k, int c) { const int kk = (k & ~0xC) | ((k & 4) << 1) | ((k & 8) >> 1); return ((kk >> 3) * 4 + (c >> 5)) * 512 + ((kk & 7) * 32 + (c & 31)) * 2; }
__device__ __forceinline__ int v_rd_base(int lane) { return ((lane & 3) << 3) | (((lane >> 2) & 3) << 6) | (((lane >> 4) & 1) << 5) | (((lane >> 5) & 1) << 8); }
constexpr int v_rd_off(int d0, int ks, int half) { return d0 * 512 + ks * 4096 + half * 2048; }
template <int OFF> __device__ __forceinline__ s16x4 tr_read(int vb) { s16x4 r; asm volatile("ds_read_b64_tr_b16 %0, %1 offset:%2" : "=&v"(r) : "v"(vb), "i"(OFF) : "memory"); return r; }
template <int D0> __device__ __forceinline__ void pv_one(f32x16& od, int vb, bf16x8 pa0, bf16x8 pa1, bf16x8 pa2, bf16x8 pa3) {
    const s16x4 l0 = tr_read<v_rd_off(D0, 0, 0)>(vb), h0 = tr_read<v_rd_off(D0, 0, 1)>(vb), l1 = tr_read<v_rd_off(D0, 1, 0)>(vb), h1 = tr_read<v_rd_off(D0, 1, 1)>(vb);
    const s16x4 l2 = tr_read<v_rd_off(D0, 2, 0)>(vb), h2 = tr_read<v_rd_off(D0, 2, 1)>(vb), l3 = tr_read<v_rd_off(D0, 3, 0)>(vb), h3 = tr_read<v_rd_off(D0, 3, 1)>(vb);
    asm volatile("s_waitcnt lgkmcnt(0)" ::: "memory"); __builtin_amdgcn_sched_barrier(0);
#define PK(L, H) (bf16x8){L[0], L[1], L[2], L[3], H[0], H[1], H[2], H[3]}
    od = __builtin_amdgcn_mfma_f32_32x32x16_bf16(pa0, PK(l0, h0), od, 0, 0, 0);
    od = __builtin_amdgcn_mfma_f32_32x32x16_bf16(pa1, PK(l1, h1), od, 0, 0, 0);
    od = __builtin_amdgcn_mfma_f32_32x32x16_bf16(pa2, PK(l2, h2), od, 0, 0, 0);
    od = __builtin_amdgcn_mfma_f32_32x32x16_bf16(pa3, PK(l3, h3), od, 0, 0, 0);
#undef PK
}
__device__ __forceinline__ void attn_unit(const bf16* Qb, const bf16* Kh, const bf16* Vh, int NT, int lw, bf16* XA, const bf16* GA, int m0, int nrows_out, LAS unsigned char* lds) {
    int tid = threadIdx.x; asm volatile("" : "+v"(tid));
    const int wid = __builtin_amdgcn_readfirstlane(tid >> 6), lane = tid & 63, r32 = lane & 31, hi = lane >> 5;
    LAS unsigned char* V_lds = lds + OFF_V; LAS unsigned char* K_lds = lds + OFF_K;
    LAS float* wsf = (LAS float*)(lds + OFF_WS) + wid * 64; LAS float* li_l = wsf; LAS float* al_l = wsf + 32;
    float m_reg = -1e30f, l_reg = 0.f; f32x16 o[4];
#pragma unroll
    for (int d = 0; d < 4; ++d)
#pragma unroll
        for (int r = 0; r < 16; ++r) o[d][r] = 0.f;
    bf16x8 qr[12];
    { const bf16* Qw = Qb + (size_t)(wid * 32 + r32) * QKD + hi * 8;
#pragma unroll
      for (int d0 = 0; d0 < 12; ++d0) qr[d0] = *(const GAS bf16x8*)(Qw + d0 * 16); }
    const int sr = tid >> 4, sc = (tid & 15) * 8, vst0 = v_st(sr, sc), vst1 = v_st(32 + sr, sc);
    unsigned kgo[3], klo[3];
#pragma unroll
    for (int i = 0; i < 3; ++i) { const int id = tid + 512 * i, kr_ = id / 24, kc_ = id - kr_ * 24; kgo[i] = (unsigned)(kr_ * (QKD * 2) + kc_ * 16); klo[i] = (unsigned)(kr_ * KROW + kc_ * 16); }
    const unsigned vgo0 = (unsigned)(sr * (VD * 2) + sc * 2), vgo1 = vgo0 + 32u * (VD * 2);
    const int vb0 = (int)(uintptr_t)(V_lds) + v_rd_base(lane);
    bf16x8 vs0, vs1, ks0, ks1, ks2;
    const GAS unsigned char* Kg = (const GAS unsigned char*)Kh; const GAS unsigned char* Vg = (const GAS unsigned char*)Vh;
#define SLOAD(k0) do { const GAS unsigned char* kt_ = Kg + (size_t)(k0) * (QKD * 2); const GAS unsigned char* vt_ = Vg + (size_t)(k0) * (VD * 2); \
        vs0 = *(const GAS bf16x8*)(vt_ + vgo0); vs1 = *(const GAS bf16x8*)(vt_ + vgo1); \
        ks0 = *(const GAS bf16x8*)(kt_ + kgo[0]); ks1 = *(const GAS bf16x8*)(kt_ + kgo[1]); ks2 = *(const GAS bf16x8*)(kt_ + kgo[2]); } while (0)
#define SWRITE(b) do { *(LAS bf16x8*)(V_lds + (b) * SHM_V + vst0) = vs0; *(LAS bf16x8*)(V_lds + (b) * SHM_V + vst1) = vs1; \
        *(LAS bf16x8*)(K_lds + (b) * SHM_K + klo[0]) = ks0; *(LAS bf16x8*)(K_lds + (b) * SHM_K + klo[1]) = ks1; *(LAS bf16x8*)(K_lds + (b) * SHM_K + klo[2]) = ks2; } while (0)
    constexpr float C = SCALE * 1.4426950408889634f;
    SLOAD(0);
    for (int j = 0; j < NT; ++j) {
        const int buf = j & 1;
        asm volatile("s_waitcnt vmcnt(0)" ::: "memory");
        SWRITE(buf);
        if (j + 1 < NT) SLOAD((j + 1) * 64);
        WG_BAR();
        if (j <= lw) {
            f32x16 p0, p1;
#pragma unroll
            for (int r = 0; r < 16; ++r) { p0[r] = 0.f; p1[r] = 0.f; }
            { const LAS unsigned char* Kb = K_lds + buf * SHM_K + r32 * KROW + hi * 16;
#pragma unroll
              for (int d0 = 0; d0 < 12; ++d0) { const bf16x8 b0 = *(const LAS bf16x8*)(Kb + d0 * 32), b1 = *(const LAS bf16x8*)(Kb + 32 * KROW + d0 * 32);
                  p0 = __builtin_amdgcn_mfma_f32_32x32x16_bf16(b0, qr[d0], p0, 0, 0, 0); p1 = __builtin_amdgcn_mfma_f32_32x32x16_bf16(b1, qr[d0], p1, 0, 0, 0); } }
            if (j == 0) {
#pragma unroll
                for (int r = 8; r < 16; ++r) p0[r] = -1e30f;
#pragma unroll
                for (int r = 0; r < 16; ++r) p1[r] = -1e30f; }
            float pmax = p0[0];
#pragma unroll
            for (int r = 1; r < 16; ++r) pmax = fmaxf(pmax, p0[r]);
#pragma unroll
            for (int r = 0; r < 16; ++r) pmax = fmaxf(pmax, p1[r]);
            { auto rr = __builtin_amdgcn_permlane32_swap(__float_as_uint(pmax), __float_as_uint(pmax), false, false); pmax = fmaxf(__uint_as_float(rr[0]), __uint_as_float(rr[1])); }
            const float mn = fmaxf(m_reg, pmax); const float alpha = __builtin_amdgcn_exp2f((m_reg - mn) * C); m_reg = mn;
            const float mnC = -mn * C;
#pragma unroll
            for (int r = 0; r < 16; ++r) { p0[r] = __builtin_amdgcn_exp2f(fmaf(p0[r], C, mnC)); p1[r] = __builtin_amdgcn_exp2f(fmaf(p1[r], C, mnC)); }
            float ps = 0.f;
#pragma unroll
            for (int r = 0; r < 16; ++r) ps += p0[r];
#pragma unroll
            for (int r = 0; r < 16; ++r) ps += p1[r];
            { auto rr = __builtin_amdgcn_permlane32_swap(__float_as_uint(ps), __float_as_uint(ps), false, false); ps = __uint_as_float(rr[0]) + __uint_as_float(rr[1]); }
            l_reg = l_reg * alpha + ps;
            if (__any(alpha < 1.f)) { if (hi == 0) al_l[r32] = alpha; asm volatile("s_waitcnt lgkmcnt(0)" ::: "memory");
#pragma unroll
                for (int r = 0; r < 16; ++r) { const float a = al_l[crow(r, hi)];
#pragma unroll
                    for (int d = 0; d < 4; ++d) o[d][r] *= a; } }
            bf16x8 pa0, pa1, pa2, pa3;
#define PK4(P, BASE, OUT) do { unsigned a0 = cvtpk(P[BASE + 0], P[BASE + 1]), a1 = cvtpk(P[BASE + 2], P[BASE + 3]); \
            unsigned b0 = cvtpk(P[BASE + 4], P[BASE + 5]), b1 = cvtpk(P[BASE + 6], P[BASE + 7]); \
            auto r0 = __builtin_amdgcn_permlane32_swap(a0, b0, false, false); auto r1 = __builtin_amdgcn_permlane32_swap(a1, b1, false, false); \
            v4u w = {r0[0], r1[0], r0[1], r1[1]}; OUT = *reinterpret_cast<bf16x8*>(&w); } while (0)
            PK4(p0, 0, pa0); PK4(p0, 8, pa1); PK4(p1, 0, pa2); PK4(p1, 8, pa3);
#undef PK4
            const int vb = vb0 + buf * SHM_V;
            pv_one<0>(o[0], vb, pa0, pa1, pa2, pa3); pv_one<1>(o[1], vb, pa0, pa1, pa2, pa3); pv_one<2>(o[2], vb, pa0, pa1, pa2, pa3); pv_one<3>(o[3], vb, pa0, pa1, pa2, pa3);
        }
    }
#undef SLOAD
#undef SWRITE
    if (hi == 0) li_l[r32] = l_reg;
    asm volatile("s_waitcnt lgkmcnt(0)" ::: "memory");
    int lane_o = lane; asm volatile("" : "+v"(lane_o));
    const int r32o = lane_o & 31, hio = lane_o >> 5;
    GAS unsigned char* xg = (GAS unsigned char*)XA; const GAS unsigned char* gg = (const GAS unsigned char*)GA;
#pragma unroll
    for (int r = 0; r < 16; ++r) { const int orow = crow(r, hio), i = wid * 32 + orow; const float rl = __builtin_amdgcn_rcpf(li_l[orow]);
        if (i < nrows_out) { const unsigned m = (unsigned)(m0 + i); const unsigned xo = m * 8192u + (unsigned)r32o * 2u, go = m * (unsigned)(NIN * 2) + (unsigned)r32o * 2u;
#pragma unroll
            for (int d0 = 0; d0 < 4; ++d0) { const float g = __uint_as_float(((unsigned)*(const GAS unsigned short*)(gg + go + d0 * 64)) << 16);
                const float val = o[d0][r] * rl * g; *(GAS unsigned short*)(xg + xo + d0 * 64) = (unsigned short)(cvtpk(val, val) & 0xffffu); } } }
    WG_BAR();
}
__device__ __forceinline__ void attn_phase(Frame& F) {
    const bf16* QA = (const bf16*)(F.ws + WS_QA); const bf16* KA = (const bf16*)(F.ws + WS_KA); const bf16* VA = (const bf16*)(F.ws + WS_VA);
    bf16* XAB = (bf16*)(F.ws + WS_XAB); const bf16* PROJ = (const bf16*)(F.ws + WS_PROJ);
    LAS unsigned char* lds = F.lds + RING_OFF;
    const int wid = F.wave;
    const int npair = (512 - F.vcu + F.G - 1) / F.G, nmeta = F.vcu < 64 ? (64 - F.vcu + F.G - 1) / F.G : 0;
#pragma unroll 1
    for (int u = 0; u < 2 * npair + nmeta; ++u) {
        int bh, qoff, NT, lw, m0, nro;
        if (u < 2 * npair) { const int p = F.vcu + (u >> 1) * F.G, pi = p & 7, qb = (u & 1) ? pi : 15 - pi; bh = p >> 3;
            qoff = 64 + 256 * qb; NT = 4 * qb + 5; lw = 4 * qb + 1 + (wid >> 1); m0 = (bh >> 4) * SEQ + 256 * qb; nro = 256; }
        else { bh = F.vcu + (u - 2 * npair) * F.G; qoff = 0; NT = 1; lw = wid == 0 ? 0 : -1; m0 = MMAIN + (bh >> 4) * N_META; nro = 16; }
        const int h = bh & 15;
        attn_unit(QA + ((size_t)bh * LP + qoff) * QKD, KA + (size_t)bh * LP * QKD, VA + (size_t)bh * LP * VD, NT, lw, XAB + h * 128, PROJ + PC_GA + h * 128, m0, nro, lds);
    }
}
}

template <int NCT, int U, class Fn>
__device__ __forceinline__ void skinny_gemm(LAS unsigned char* lds, const bf16* A, int lda, const bf16* Bt, int ldb, int N, int K, int grp_cols, int a_grp_stride, int cu, int first_cu, int ncus, int G, const Fn& fn) {
    int tid = threadIdx.x; asm volatile("" : "+v"(tid));
    const int wave = __builtin_amdgcn_readfirstlane(tid >> 6), lane = tid & 63, fr = lane & 15, fq = lane >> 4;
    int rel = cu - first_cu; if (rel < 0) rel += G;
    if (rel >= ncus) return;
    const int nitems = N / (16 * NCT), ksl = K >> 3, k0 = wave * ksl;
    constexpr int PW = 64 * 16 * NCT;
#pragma unroll 1
    for (int item = rel; item < nitems; item += ncus) {
        const int n0 = item * 16 * NCT; const int acol = grp_cols ? (n0 / grp_cols) * a_grp_stride : 0;
        pg8::f32x4 acc[4][NCT];
#pragma unroll
        for (int rt = 0; rt < 4; ++rt)
#pragma unroll
            for (int ct = 0; ct < NCT; ++ct) acc[rt][ct] = (pg8::f32x4){0.f, 0.f, 0.f, 0.f};
        const GAS unsigned char* ap = (const GAS unsigned char*)(A + (size_t)fr * lda + acol + k0 + fq * 8);
        const GAS unsigned char* bp = (const GAS unsigned char*)(Bt + (size_t)(n0 + fr) * ldb + k0 + fq * 8);
        const unsigned astep = (unsigned)lda * 32u, bstep = (unsigned)ldb * 32u;
#pragma unroll 1
        for (int ks = 0; ks < ksl; ks += 32 * U) {
            bf16x8 a[U][4], b[U][NCT];
#pragma unroll
            for (int u = 0; u < U; ++u) {
#pragma unroll
                for (int rt = 0; rt < 4; ++rt) a[u][rt] = *(const GAS bf16x8*)(ap + rt * astep + (ks + 32 * u) * 2);
#pragma unroll
                for (int ct = 0; ct < NCT; ++ct) b[u][ct] = *(const GAS bf16x8*)(bp + ct * bstep + (ks + 32 * u) * 2); }
            __builtin_amdgcn_sched_barrier(0);
#pragma unroll
            for (int u = 0; u < U; ++u)
#pragma unroll
                for (int rt = 0; rt < 4; ++rt)
#pragma unroll
                    for (int ct = 0; ct < NCT; ++ct) acc[rt][ct] = __builtin_amdgcn_mfma_f32_16x16x32_bf16(b[u][ct], a[u][rt], acc[rt][ct], 0, 0, 0);
        }
        LAS float* P = (LAS float*)lds + wave * PW;
#pragma unroll
        for (int rt = 0; rt < 4; ++rt)
#pragma unroll
            for (int ct = 0; ct < NCT; ++ct) *(LAS pg8::f32x4*)(P + (rt * 16 + fr) * (16 * NCT) + ct * 16 + 4 * fq) = acc[rt][ct];
        WG_BAR();
        for (int c = tid; c < 64 * 4 * NCT; c += NWAVES * 64) { const int row = c / (4 * NCT), cc = (c - row * (4 * NCT)) * 4; const LAS float* p = (const LAS float*)lds + row * (16 * NCT) + cc;
            pg8::f32x4 vA = *(const LAS pg8::f32x4*)p, vB = *(const LAS pg8::f32x4*)(p + 4 * PW);
#pragma unroll
            for (int w = 1; w < 4; ++w) { vA += *(const LAS pg8::f32x4*)(p + w * PW); vB += *(const LAS pg8::f32x4*)(p + (4 + w) * PW); }
            fn(MMAIN + row, n0 + cc, vA, vB); }
        WG_BAR();
    }
}
__device__ __forceinline__ v2u pack4(const pg8::f32x4& v) { v2u w; w.x = cvtpk(v[0], v[1]); w.y = cvtpk(v[2], v[3]); return w; }
__device__ __forceinline__ float sigm(float x) { return __builtin_amdgcn_rcpf(1.0f + __builtin_amdgcn_exp2f(-1.4426950408889634f * x)); }
struct SkProj { bf16* O; const float* ss;
    __device__ __forceinline__ void operator()(int row, int col, pg8::f32x4 a, pg8::f32x4 b) const { pg8::f32x4 v = (a + b) * (1.0f / sqrtf(ss[row] * (1.0f / 4096.0f) + NORM_EPS));
        if (col >= PC_GA && col < PC_KR) {
#pragma unroll
            for (int j = 0; j < 4; ++j) { const float sg = sigm(v[j]); v[j] = col < PC_MA ? v[j] * sg : sg; } }
        *(GAS v2u*)(O + (size_t)row * NIN + col) = pack4(v); } };
struct SkPlain { bf16* O; int ldc;
    __device__ __forceinline__ void operator()(int row, int col, pg8::f32x4 a, pg8::f32x4 b) const { *(GAS v2u*)(O + (size_t)row * ldc + col) = pack4(a + b); } };
struct SkKV { bf16* KRAW; bf16* VA;
    __device__ __forceinline__ void operator()(int row, int col, pg8::f32x4 a, pg8::f32x4 b) const { const int h = col >> 8, c = col & 255; const v2u w = pack4(a + b);
        if (c < 128) *(GAS v2u*)(KRAW + (size_t)row * 2048 + h * 128 + c) = w;
        else { const int j = row - MMAIN, bb = j >> 4, pp = j & 15; *(GAS v2u*)(VA + ((size_t)(bb * 16 + h) * LP + pp) * 128 + (c - 128)) = w; } } };
struct SkPool { bf16* XAB; const bf16* PROJ; const float* scale;
    __device__ __forceinline__ void operator()(int row, int col, pg8::f32x4 a, pg8::f32x4 b) const { const pg8::f32x4 sc = *(const GAS pg8::f32x4*)(scale + col); const v2u g = *(const GAS v2u*)(PROJ + (size_t)row * NIN + PC_GB + col);
        pg8::f32x4 v = (a + b) * sc; v[0] *= bflo(g.x); v[1] *= bfhi(g.x); v[2] *= bflo(g.y); v[3] *= bfhi(g.y); *(GAS v2u*)(XAB + (size_t)row * 4096 + 2048 + col) = pack4(v); } };
struct SkBranch { bf16* MG; const bf16* PROJ;
    __device__ __forceinline__ void operator()(int row, int col, pg8::f32x4 a, pg8::f32x4 b) const { const v2u ga = *(const GAS v2u*)(PROJ + (size_t)row * NIN + PC_MA + col), gb = *(const GAS v2u*)(PROJ + (size_t)row * NIN + PC_MB + col);
        pg8::f32x4 v; v[0] = a[0] * bflo(ga.x) + b[0] * bflo(gb.x); v[1] = a[1] * bfhi(ga.x) + b[1] * bfhi(gb.x); v[2] = a[2] * bflo(ga.y) + b[2] * bflo(gb.y); v[3] = a[3] * bfhi(ga.y) + b[3] * bfhi(gb.y);
        *(GAS v2u*)(MG + (size_t)row * 4096 + col) = pack4(v); } };
struct SkRes { float* H; bf16* HG; const float* gnext; float* SSN;
    __device__ __forceinline__ void operator()(int row, int col, pg8::f32x4 a, pg8::f32x4 b) const { const size_t off = (size_t)row * 4096 + col; const pg8::f32x4 h = *(const GAS pg8::f32x4*)(H + off) + a + b; const pg8::f32x4 g = *(const GAS pg8::f32x4*)(gnext + col);
        *(GAS pg8::f32x4*)(H + off) = h; *(GAS v2u*)(HG + off) = pack4(h * g); atomicAdd(SSN + row, (h[0] * h[0] + h[1] * h[1]) + (h[2] * h[2] + h[3] * h[3])); } };

__device__ __forceinline__ int opaque_reps(int n) { if (DBLMASK) asm volatile("" : "+s"(n)); return n; }
struct Args { const float* in[15]; float* out; unsigned char* ws; int ph_lo, ph_hi; };
constexpr int NPHASE = 1 + 7 * DEPTH;

__global__ void __launch_bounds__(NWAVES * 64, 2) trunk_fwd(Args args) {
    extern __shared__ __attribute__((aligned(16))) unsigned char lds_raw[];
    Frame F;
    F.lds = (LAS unsigned char*)lds_raw;
    F.tid = threadIdx.x; F.lane = F.tid & 63; F.wave = __builtin_amdgcn_readfirstlane(F.tid >> 6);
    F.G = gridDim.x; { const int bx = blockIdx.x; F.vcu = (F.G % 8 == 0) ? (bx % 8) * (F.G / 8) + bx / 8 : bx; }
    F.ws = args.ws; F.out = args.out;
#pragma unroll
    for (int i = 0; i < 15; ++i) F.in[i] = args.in[i];
    volatile LAS unsigned* MISC = (volatile LAS unsigned*)(F.lds + MISC_OFF);
    for (int u = F.tid; u < (LDS_BYTES - LDSCTL_OFF) / 4; u += NWAVES * 64) ((LAS unsigned*)(F.lds + LDSCTL_OFF))[u] = 0u;
    __syncthreads();
    unsigned* ctl = (unsigned*)(F.ws + WS_CTL);
    XcdBarrier bar; bar.bar = ctl + CW_BAR; bar.x = 0; bar.st = nullptr;
    if (!MK_PER_PHASE) bar = xcd_barrier_post(ctl + CW_BAR, MISC + 8);
    const int lo = args.ph_lo, hi = args.ph_hi;
#define IN(k) (lo <= (k) && (k) < hi)
#ifndef PHMASK
#define PHMASK 0xFFFF
#endif
#define EN(b) ((PHMASK >> (b)) & 1)
#define DBL(b) ((DBLMASK >> (b)) & 1)
#define REPEAT(b) _Pragma("unroll 1") for (int rep_ = 0, nrep_ = opaque_reps(DBL(b) ? 2 : 1); rep_ < nrep_; ++rep_)
#define SEAM(k) do { if (!MK_PER_PHASE && IN((k) + 1)) xcd_barrier(bar); } while (0)

    if (EN(0) && IN(0)) { REPEAT(0) { p0_prologue(F); VM_WAIT(); __syncthreads(); } SEAM(0); }

    for (int l = 0; l < DEPTH; ++l) {
        const int pb = 1 + 7 * l; const bool lastl = (l == DEPTH - 1);
        unsigned char* wl = F.ws + WS_W + (size_t)l * WL_SIZE;
        bf16* PROJ = (bf16*)(F.ws + WS_PROJ);
        const float* SSc = (const float*)(F.ws + WS_SS) + (size_t)(l & 1) * MP; float* SSn = (float*)(F.ws + WS_SS) + (size_t)((l + 1) & 1) * MP;
        if (EN(2) && IN(pb + 0)) {
            pg8::Gemm g{(const bf16*)(F.ws + WS_HN), (const bf16*)(wl + WL_IN), 4096, 4096, 4096}; pg8::StaticOrder S; S.init(MMAIN, NIN, F.G, (int)blockIdx.x);
            pg8::EpiProj E{PROJ, NIN, 14, 30, 30, 62, SSc};
            REPEAT(2) pg8::gemm_phase<pg8::EpiProj, pg8::StaticOrder, PG8_ALIGN, PG8_SP2>(F.lds + RING_OFF, g, S, E);
            REPEAT(12) skinny_gemm<4, 2>(F.lds + RING_OFF, (const bf16*)(F.ws + WS_HN) + (size_t)MMAIN * 4096, 4096, (const bf16*)(wl + WL_IN), 4096, IN_WIDTH, 4096, 0, 0, (int)blockIdx.x, (4032 % F.G), F.G - (4032 % F.G), F.G, SkProj{PROJ, SSc});
            SEAM(pb + 0); }
        if (EN(3) && IN(pb + 1)) { REPEAT(3) p3_latent(F, F.in[I_QLG] + (size_t)l * 1024, F.in[I_KVLG] + (size_t)l * 512, lastl ? nullptr : SSn); SEAM(pb + 1); }
        if (IN(pb + 2)) {
            if (EN(4)) {
                pg8::Gemm g{(const bf16*)(F.ws + WS_CQN), (const bf16*)(wl + WL_UQ), 1024, 1024, 1024}; pg8::StaticOrder S; S.init(MMAIN, 3072, F.G, (int)blockIdx.x);
                pg8::EpiProj E{(bf16*)(F.ws + WS_QRAW), 3072, 0, 0, 0, 0, nullptr};
                REPEAT(4) pg8::gemm_phase<pg8::EpiProj, pg8::StaticOrder, PG8_ALIGN, PG8_SP2>(F.lds + RING_OFF, g, S, E);
                REPEAT(12) skinny_gemm<1, 4>(F.lds + RING_OFF, (const bf16*)(F.ws + WS_CQN) + (size_t)MMAIN * 1024, 1024, (const bf16*)(wl + WL_UQ), 1024, 3072, 1024, 0, 0, (int)blockIdx.x, 0, F.G, F.G, SkPlain{(bf16*)(F.ws + WS_QRAW), 3072}); }
            if (EN(5)) {
                pg8::Gemm g{(const bf16*)(F.ws + WS_CKVN), (const bf16*)(wl + WL_UKV), 512, 512, 512}; pg8::StaticOrder S; S.init(MMAIN, 4096, F.G, (int)blockIdx.x);
                pg8::EpiKV E{(bf16*)(F.ws + WS_KRAW), (bf16*)(F.ws + WS_VA), LP};
                REPEAT(5) pg8::gemm_phase<pg8::EpiKV, pg8::StaticOrder, PG8_ALIGN, PG8_SP2>(F.lds + RING_OFF, g, S, E);
                REPEAT(12) skinny_gemm<1, 2>(F.lds + RING_OFF, (const bf16*)(F.ws + WS_CKVN) + (size_t)MMAIN * 512, 512, (const bf16*)(wl + WL_UKV), 512, 4096, 512, 0, 0, (int)blockIdx.x, 0, F.G, F.G, SkKV{(bf16*)(F.ws + WS_KRAW), (bf16*)(F.ws + WS_VA)}); }
            if (EN(6)) {
                pg8::Gemm g{(const bf16*)(F.ws + WS_DIFF), (const bf16*)(wl + WL_POOL), 2048, 512, 512}; pg8::PoolOrder S; S.init(MMAIN, 2048, F.G, (int)blockIdx.x);
                pg8::EpiPool E{(bf16*)(F.ws + WS_XAB) + 2048, PROJ + PC_GB, NIN, F.in[I_PSCALE] + (size_t)l * 2048};
                REPEAT(6) pg8::gemm_phase<pg8::EpiPool, pg8::PoolOrder, PG8_ALIGN, PG8_SP2>(F.lds + RING_OFF, g, S, E);
                REPEAT(12) skinny_gemm<1, 2>(F.lds + RING_OFF, (const bf16*)(F.ws + WS_DIFF) + (size_t)MMAIN * 2048, 2048, (const bf16*)(wl + WL_POOL), 512, 2048, 512, 512, 512, (int)blockIdx.x, 0, F.G, F.G, SkPool{(bf16*)(F.ws + WS_XAB), PROJ, F.in[I_PSCALE] + (size_t)l * 2048}); }
            SEAM(pb + 2); }
        if (EN(7) && IN(pb + 3)) { REPEAT(7) p5_qknorm(F, F.in[I_QHG] + (size_t)l * 192, F.in[I_KHG] + (size_t)l * 192); SEAM(pb + 3); }
        if (EN(8) && IN(pb + 4)) { REPEAT(8) att::attn_phase(F); SEAM(pb + 4); }
        if (IN(pb + 5)) {
            if (EN(9)) {
                pg8::Gemm g{(const bf16*)(F.ws + WS_XAB), (const bf16*)(wl + WL_AB), 4096, 4096, 4096}; pg8::StaticOrder S; S.init(MMAIN, 4096, F.G, (int)blockIdx.x);
                pg8::EpiBranch E{(bf16*)(F.ws + WS_MG), PROJ + PC_MA, PROJ + PC_MB, NIN};
                REPEAT(9) pg8::gemm_phase<pg8::EpiBranch, pg8::StaticOrder, PG8_ALIGN, PG8_SP2>(F.lds + RING_OFF, g, S, E);
                if (!lastl) REPEAT(12) skinny_gemm<1, 8>(F.lds + RING_OFF, (const bf16*)(F.ws + WS_XAB) + (size_t)MMAIN * 4096, 4096, (const bf16*)(wl + WL_AB), 4096, 4096, 4096, 0, 0, (int)blockIdx.x, 0, F.G, F.G, SkBranch{(bf16*)(F.ws + WS_MG), PROJ}); }
            SEAM(pb + 5); }
        if (EN(11) && IN(pb + 6)) {
            pg8::Gemm g{(const bf16*)(F.ws + WS_MG), (const bf16*)(wl + WL_OUT), 4096, 4096, 4096}; pg8::StaticOrder S; S.init(MMAIN, 4096, F.G, (int)blockIdx.x);
            const float* gnext = F.in[I_NORMG] + (size_t)(lastl ? l : l + 1) * 4096;
            pg8::EpiRes E{(float*)(F.ws + WS_H), lastl ? F.out : nullptr, (bf16*)(F.ws + WS_HN), gnext, SSn};
            pg8::gemm_phase<pg8::EpiRes, pg8::StaticOrder, PG8_ALIGN, PG8_SP2>(F.lds + RING_OFF, g, S, E);
            if (!lastl) skinny_gemm<1, 8>(F.lds + RING_OFF, (const bf16*)(F.ws + WS_MG) + (size_t)MMAIN * 4096, 4096, (const bf16*)(wl + WL_OUT), 4096, 4096, 4096, 0, 0, (int)blockIdx.x, 0, F.G, F.G, SkRes{(float*)(F.ws + WS_H), (bf16*)(F.ws + WS_HN), gnext, SSn});
            SEAM(pb + 6); }
    }
#undef IN
#undef SEAM
}

extern "C" void kernel_launch(void* const* d_in, const int* in_sizes, int n_in, void* d_out, int out_size, void* d_ws, size_t ws_size, hipStream_t stream) {
    static int grid = 0;
    if (grid == 0) {
        if (n_in != 15 || out_size != BATCH * SEQ * D_MODEL || ws_size < WS_END) { fprintf(stderr, "kernel_launch: unexpected shapes (n_in %d out %d ws %zu need %zu)\n", n_in, out_size, ws_size, (size_t)WS_END); grid = -1; return; }
        int dev = 0, cus = 0, per_cu = 0;
        if (hipGetDevice(&dev) != hipSuccess || hipDeviceGetAttribute(&cus, hipDeviceAttributeMultiprocessorCount, dev) != hipSuccess) { grid = -1; return; }
        if (hipFuncSetAttribute((const void*)trunk_fwd, hipFuncAttributeMaxDynamicSharedMemorySize, LDS_BYTES) != hipSuccess) { fprintf(stderr, "kernel_launch: hipFuncSetAttribute failed\n"); grid = -1; return; }
        if (hipOccupancyMaxActiveBlocksPerMultiprocessor(&per_cu, (const void*)trunk_fwd, NWAVES * 64, LDS_BYTES) != hipSuccess || per_cu < 1) fprintf(stderr, "kernel_launch: occupancy query says %d\n", per_cu);
        (void)hipGetLastError();
        grid = cus;
    }
    if (grid < 0) return;
    if (hipMemsetAsync((char*)d_ws + WS_CTL, 0, CTL_ZERO_BYTES, stream) != hipSuccess) return;
    Args a{};
    for (int i = 0; i < 15; ++i) a.in[i] = (const float*)d_in[i];
    a.out = (float*)d_out; a.ws = (unsigned char*)d_ws;
#if MK_PER_PHASE
    for (int p = 0; p < NPHASE; ++p) { a.ph_lo = p; a.ph_hi = p + 1; hipLaunchKernelGGL(trunk_fwd, dim3(grid), dim3(NWAVES * 64), LDS_BYTES, stream, a); }
#else
    a.ph_lo = 0; a.ph_hi = NPHASE; hipLaunchKernelGGL(trunk_fwd, dim3(grid), dim3(NWAVES * 64), LDS_BYTES, stream, a);
#endif
    (void)in_sizes;
}
```

```cpp
#include <hip/hip_runtime.h>
#include <cstdio>
#include <cstdint>

#ifndef MK_PER_PHASE
#define MK_PER_PHASE 0
#endif

namespace pg8 {
#define PG8_LAS __attribute__((address_space(3)))
typedef unsigned short bf16_t;
typedef short bf16x8 __attribute__((ext_vector_type(8)));
typedef float f32x4 __attribute__((ext_vector_type(4)));
typedef unsigned u32x4 __attribute__((ext_vector_type(4)));
constexpr int BM = 256, BK = 64, HALF = 128, HTB = HALF * BK * 2  , STAGE_BYTES = 8 * HTB, NXCD = 8, WGM = 4;

__host__ __device__ __forceinline__ int lds_byte(int r, int c) { const int st = (r >> 4) * 2 + (c >> 5), rr = r & 15, cc = c & 31, ob = rr * 64 + cc * 2; return st * 1024 + (ob ^ (((ob >> 9) & 1) << 5)); }
__host__ __device__ __forceinline__ void stage_rc(int b, int& R, int& C) { const int st = b / 1024, sb = b % 1024, swz = sb ^ (((sb >> 9) & 1) << 5); R = (st >> 1) * 16 + swz / 64; C = (st & 1) * 32 + (swz % 64) / 2; }
__host__ __device__ __forceinline__ int perm32(int rho) { const int n = rho >> 4, i = rho & 15; return 8 * (i >> 2) + 4 * n + (i & 3); }

struct Unit { int pm, pn; unsigned aoff; };
struct Gemm { const bf16_t* A; const bf16_t* Bt; int lda, ldb, K; };

struct StaticOrder {
    int nM, nN, nwg, G, c;
    __host__ __device__ void init(int M, int N, int G_, int c_) { nM = M / BM; nN = N / BM; nwg = nM * nN; G = G_; c = c_; }
    __host__ __device__ bool next(int i, Unit& u) const {
        const long L = (long)i * G + c; if (L >= nwg) return false;
        int wgid = (int)L; { const int q = nwg / NXCD, r = nwg % NXCD, xcd = wgid % NXCD, off = wgid / NXCD; wgid = (xcd < r ? xcd * (q + 1) : r * (q + 1) + (xcd - r) * q) + off; }
        const int nig = WGM * nN, gid = wgid / nig, fm = gid * WGM, gsz = (nM - fm) < WGM ? (nM - fm) : WGM;
        u.pm = fm + ((wgid % nig) % gsz); u.pn = (wgid % nig) / gsz; u.aoff = 0u; return true;
    }
    __device__ __forceinline__ void a_ready(const Unit&) const {}
    __device__ __forceinline__ void done(const Unit&) const {}
};
__device__ __forceinline__ unsigned cvt_pk_bf16(float lo, float hi) { unsigned r; asm volatile("v_cvt_pk_bf16_f32 %0, %1, %2" : "=v"(r) : "v"(lo), "v"(hi)); return r; }
typedef unsigned u32x2 __attribute__((ext_vector_type(2)));
__device__ __forceinline__ float bflo(unsigned u) { return __uint_as_float(u << 16); }
__device__ __forceinline__ float bfhi(unsigned u) { return __uint_as_float(u & 0xffff0000u); }
__device__ __forceinline__ float sigmoidf_(float x) { return __builtin_amdgcn_rcpf(1.0f + __builtin_amdgcn_exp2f(-1.4426950408889634f * x)); }


#ifndef NT_STORE
#define NT_STORE 0
#endif
struct EpiProj {
    static constexpr bool PERM = true, AFTER_DRAIN = false, MID = false; static constexpr int TAG = 9;
    bf16_t* O; int ldc; int silu_lo, silu_hi, sig_lo, sig_hi; const float* ss; float inv_n; float* partq; int pq_tiles, pq_stride;
    __device__ __forceinline__ void operator()(const f32x4 (&acc)[2][2][4][2], const Unit& u, int wr, int wc, int fr, int fq) const {
        const int row0 = u.pm * BM + wr * 64 + fr; const int col0 = u.pn * BM + wc * 32 + 8 * fq;
        const int act = (u.pn >= silu_lo && u.pn < silu_hi) ? 1 : ((u.pn >= sig_lo && u.pn < sig_hi) ? 2 : 0);
        float rs[2][4];
#pragma unroll
        for (int ai = 0; ai < 2; ++ai)
#pragma unroll
            for (int m = 0; m < 4; ++m) rs[ai][m] = ss ? ss[row0 + ai * HALF + m * 16] : 0.f;
        __builtin_amdgcn_sched_barrier(0);
#pragma unroll
        for (int ai = 0; ai < 2; ++ai)
#pragma unroll
            for (int m = 0; m < 4; ++m) { const int row = row0 + ai * HALF + m * 16; bf16_t* rowp = O + (size_t)row * ldc + col0;
                const float r = ss ? 1.0f / sqrtf(rs[ai][m] * inv_n + 1e-6f) : 1.0f;
                if (act == 2) {
                    f32x4 a0 = acc[ai][0][m][0] * r, a1 = acc[ai][0][m][1] * r, b0 = acc[ai][1][m][0] * r, b1 = acc[ai][1][m][1] * r;
#pragma unroll
                    for (int j = 0; j < 4; ++j) { const float sb0 = fmaxf(sigmoidf_(b0[j]), 1e-6f), sb1 = fmaxf(sigmoidf_(b1[j]), 1e-6f);
                        a0[j] = sigmoidf_(a0[j]) * __builtin_amdgcn_rcpf(sb0); a1[j] = sigmoidf_(a1[j]) * __builtin_amdgcn_rcpf(sb1); b0[j] = sb0; b1[j] = sb1; }
                    u32x4 w; w.x = cvt_pk_bf16(a0[0], a0[1]); w.y = cvt_pk_bf16(a0[2], a0[3]); w.z = cvt_pk_bf16(a1[0], a1[1]); w.w = cvt_pk_bf16(a1[2], a1[3]); *(u32x4*)rowp = w;
                    w.x = cvt_pk_bf16(b0[0], b0[1]); w.y = cvt_pk_bf16(b0[2], b0[3]); w.z = cvt_pk_bf16(b1[0], b1[1]); w.w = cvt_pk_bf16(b1[2], b1[3]); *(u32x4*)(rowp + HALF) = w;
                } else {
                float psq = 0.f;
#pragma unroll
                for (int bj = 0; bj < 2; ++bj) { f32x4 v0 = acc[ai][bj][m][0] * r, v1 = acc[ai][bj][m][1] * r;
                    psq += ((v0[0] * v0[0] + v0[1] * v0[1]) + (v0[2] * v0[2] + v0[3] * v0[3])) + ((v1[0] * v1[0] + v1[1] * v1[1]) + (v1[2] * v1[2] + v1[3] * v1[3]));
                    if (act) {
#pragma unroll
                        for (int j = 0; j < 4; ++j) { const float s0 = sigmoidf_(v0[j]), s1 = sigmoidf_(v1[j]); v0[j] = v0[j] * s0; v1[j] = v1[j] * s1; } }
                    u32x4 w; w.x = cvt_pk_bf16(v0[0], v0[1]); w.y = cvt_pk_bf16(v0[2], v0[3]); w.z = cvt_pk_bf16(v1[0], v1[1]); w.w = cvt_pk_bf16(v1[2], v1[3]);
                    if (NT_STORE) __builtin_nontemporal_store(w, (u32x4*)(rowp + bj * HALF)); else *(u32x4*)(rowp + bj * HALF) = w; }
                if (partq && u.pn < pq_tiles) { psq += __shfl_xor(psq, 16); psq += __shfl_xor(psq, 32); if (fq == 0) partq[(size_t)(u.pn * 4 + wc) * pq_stride + row] = psq; } } }
    }
};
struct EpiKV {
    static constexpr bool PERM = true, AFTER_DRAIN = false, MID = false; static constexpr int TAG = 10;
    bf16_t* KRAW; bf16_t* VA; int lp; const float* ss;
    __device__ __forceinline__ void operator()(const f32x4 (&acc)[2][2][4][2], const Unit& u, int wr, int wc, int fr, int fq) const {
        const int row0 = u.pm * BM + wr * 64 + fr; const int h = u.pn; const int c0 = wc * 32 + 8 * fq;
        float rs[2][4];
#pragma unroll
        for (int ai = 0; ai < 2; ++ai)
#pragma unroll
            for (int m = 0; m < 4; ++m) rs[ai][m] = ss[row0 + ai * HALF + m * 16];
        __builtin_amdgcn_sched_barrier(0);
#pragma unroll
        for (int ai = 0; ai < 2; ++ai)
#pragma unroll
            for (int m = 0; m < 4; ++m) { const int row = row0 + ai * HALF + m * 16; const float r = 1.0f / sqrtf(rs[ai][m] * (1.0f / 512.0f) + 1e-6f);
                { const f32x4 v0 = acc[ai][0][m][0] * r, v1 = acc[ai][0][m][1] * r; u32x4 w; w.x = cvt_pk_bf16(v0[0], v0[1]); w.y = cvt_pk_bf16(v0[2], v0[3]); w.z = cvt_pk_bf16(v1[0], v1[1]); w.w = cvt_pk_bf16(v1[2], v1[3]);
                  *(u32x4*)(KRAW + (size_t)row * 2048 + h * 128 + c0) = w; }
                { const int b = row >> 12, pp = 64 + (row & 4095);
                  const f32x4 v0 = acc[ai][1][m][0] * r, v1 = acc[ai][1][m][1] * r; u32x4 w; w.x = cvt_pk_bf16(v0[0], v0[1]); w.y = cvt_pk_bf16(v0[2], v0[3]); w.z = cvt_pk_bf16(v1[0], v1[1]); w.w = cvt_pk_bf16(v1[2], v1[3]);
                  *(u32x4*)(VA + ((size_t)(b * 16 + h) * lp + pp) * 128 + c0) = w; } }
    }
};
struct EpiPool {
    static constexpr bool PERM = true, AFTER_DRAIN = false, MID = false; static constexpr int TAG = 11;
    bf16_t* XAB; const bf16_t* GB; int ldg; const float* scale;
    __device__ __forceinline__ void operator()(const f32x4 (&acc)[2][2][4][2], const Unit& u, int wr, int wc, int fr, int fq) const {
        const int row0 = u.pm * BM + wr * 64 + fr; const int col0 = u.pn * BM + wc * 32 + 8 * fq;
        f32x4 sc[2][2]; u32x4 g[2][4][2];
#pragma unroll
        for (int bj = 0; bj < 2; ++bj)
#pragma unroll
            for (int n = 0; n < 2; ++n) sc[bj][n] = *(const f32x4*)(scale + col0 + bj * HALF + 4 * n);
#pragma unroll
        for (int ai = 0; ai < 2; ++ai)
#pragma unroll
            for (int m = 0; m < 4; ++m)
#pragma unroll
                for (int bj = 0; bj < 2; ++bj) g[ai][m][bj] = *(const u32x4*)((const char*)GB + ((unsigned)(row0 + ai * HALF + m * 16) * (unsigned)ldg + (unsigned)(col0 + bj * HALF)) * 2u);
        __builtin_amdgcn_sched_barrier(0);
#pragma unroll
        for (int ai = 0; ai < 2; ++ai)
#pragma unroll
            for (int m = 0; m < 4; ++m) { const size_t row = (size_t)(row0 + ai * HALF + m * 16);
#pragma unroll
                for (int bj = 0; bj < 2; ++bj) { const u32x4 gg = g[ai][m][bj];
                    const f32x4 v0 = acc[ai][bj][m][0] * sc[bj][0], v1 = acc[ai][bj][m][1] * sc[bj][1];
                    u32x4 w; w.x = cvt_pk_bf16(v0[0] * bflo(gg.x), v0[1] * bfhi(gg.x)); w.y = cvt_pk_bf16(v0[2] * bflo(gg.y), v0[3] * bfhi(gg.y));
                    w.z = cvt_pk_bf16(v1[0] * bflo(gg.z), v1[1] * bfhi(gg.z)); w.w = cvt_pk_bf16(v1[2] * bflo(gg.w), v1[3] * bfhi(gg.w));
                    *(u32x4*)(XAB + row * 4096 + col0 + bj * HALF) = w; } }
    }
};
__device__ __forceinline__ float gate_b(float s) { return fmaxf(s, 1e-6f); }
struct EpiBranch {
    static constexpr bool PERM = true, AFTER_DRAIN = false, MID = true; static constexpr int TAG = 12;
    bf16_t* MG; const bf16_t* RS; int ldg;
    __device__ __forceinline__ void mid(f32x4 (&acc)[2][2][4][2], const Unit& u, int wr, int wc, int fr, int fq) const {
        asm volatile("" : "+v"(fr), "+v"(fq));
        const int row0 = u.pm * BM + wr * 64 + fr; const int gc0 = u.pn * 512 + wc * 32 + 8 * fq;
        u32x4 a[2][4][2];
#pragma unroll
        for (int ai = 0; ai < 2; ++ai)
#pragma unroll
            for (int m = 0; m < 4; ++m)
#pragma unroll
                for (int bj = 0; bj < 2; ++bj) a[ai][m][bj] = *(const u32x4*)((const char*)RS + ((unsigned)(row0 + ai * HALF + m * 16) * (unsigned)ldg + (unsigned)(gc0 + 256 * bj)) * 2u);
        __builtin_amdgcn_sched_barrier(0);
#pragma unroll
        for (int ai = 0; ai < 2; ++ai)
#pragma unroll
            for (int m = 0; m < 4; ++m)
#pragma unroll
                for (int bj = 0; bj < 2; ++bj) { const u32x4 aa = a[ai][m][bj]; f32x4 r0, r1;
                    r0[0] = bflo(aa.x); r0[1] = bfhi(aa.x); r0[2] = bflo(aa.y); r0[3] = bfhi(aa.y); r1[0] = bflo(aa.z); r1[1] = bfhi(aa.z); r1[2] = bflo(aa.w); r1[3] = bfhi(aa.w);
                    acc[ai][bj][m][0] *= r0; acc[ai][bj][m][1] *= r1; }
        __builtin_amdgcn_sched_barrier(0);
    }
    __device__ __forceinline__ void operator()(const f32x4 (&acc)[2][2][4][2], const Unit& u, int wr, int wc, int fr, int fq) const {
        const int row0 = u.pm * BM + wr * 64 + fr; const int col0 = u.pn * BM + wc * 32 + 8 * fq, gc0 = u.pn * 512 + wc * 32 + 8 * fq + 128;
        u32x4 g[2][4][2];
#pragma unroll
        for (int ai = 0; ai < 2; ++ai)
#pragma unroll
            for (int m = 0; m < 4; ++m)
#pragma unroll
                for (int bj = 0; bj < 2; ++bj) g[ai][m][bj] = *(const u32x4*)((const char*)RS + ((unsigned)(row0 + ai * HALF + m * 16) * (unsigned)ldg + (unsigned)(gc0 + 256 * bj)) * 2u);
        __builtin_amdgcn_sched_barrier(0);
#pragma unroll
        for (int ai = 0; ai < 2; ++ai)
#pragma unroll
            for (int m = 0; m < 4; ++m) { const size_t row = (size_t)(row0 + ai * HALF + m * 16);
#pragma unroll
                for (int bj = 0; bj < 2; ++bj) { const u32x4 b = g[ai][m][bj]; const f32x4 v0 = acc[ai][bj][m][0], v1 = acc[ai][bj][m][1];
                    u32x4 w; w.x = cvt_pk_bf16(v0[0] * bflo(b.x), v0[1] * bfhi(b.x)); w.y = cvt_pk_bf16(v0[2] * bflo(b.y), v0[3] * bfhi(b.y));
                    w.z = cvt_pk_bf16(v1[0] * bflo(b.z), v1[1] * bfhi(b.z)); w.w = cvt_pk_bf16(v1[2] * bflo(b.w), v1[3] * bfhi(b.w));
                    *(u32x4*)(MG + row * 4096 + col0 + bj * HALF) = w; } }
    }
};
struct EpiRes {
    static constexpr bool PERM = true, AFTER_DRAIN = false, MID = false; static constexpr int TAG = 13;
    bf16_t* HB; float* OUT; float* PARTM;
    __device__ __forceinline__ void operator()(const f32x4 (&acc)[2][2][4][2], const Unit& u, int wr, int wc, int fr, int fq) const {
        const int row0 = u.pm * BM + wr * 64 + fr, col0 = u.pn * BM + wc * 32 + 8 * fq;
#pragma unroll
        for (int ai = 0; ai < 2; ++ai) {
            u32x4 hv[4][2];
#pragma unroll
            for (int m = 0; m < 4; ++m)
#pragma unroll
                for (int bj = 0; bj < 2; ++bj) hv[m][bj] = *(const u32x4*)(HB + (size_t)(row0 + ai * HALF + m * 16) * 4096 + col0 + bj * HALF);
            __builtin_amdgcn_sched_barrier(0);
            if (OUT) {
#pragma unroll
                for (int m = 0; m < 4; ++m)
#pragma unroll
                    for (int bj = 0; bj < 2; ++bj) { const u32x4 r = hv[m][bj]; float* o = OUT + (size_t)(row0 + ai * HALF + m * 16) * 4096 + col0 + bj * HALF;
                        f32x4 h0, h1; h0[0] = bflo(r.x); h0[1] = bfhi(r.x); h0[2] = bflo(r.y); h0[3] = bfhi(r.y); h1[0] = bflo(r.z); h1[1] = bfhi(r.z); h1[2] = bflo(r.w); h1[3] = bfhi(r.w);
                        *(f32x4*)o = h0 + acc[ai][bj][m][0]; *(f32x4*)(o + 4) = h1 + acc[ai][bj][m][1]; }
            } else {
#pragma unroll
                for (int m = 0; m < 4; ++m) { const int row = row0 + ai * HALF + m * 16; float ssum = 0.f;
#pragma unroll
                    for (int bj = 0; bj < 2; ++bj) { const u32x4 r = hv[m][bj];
                        f32x4 h0, h1; h0[0] = bflo(r.x); h0[1] = bfhi(r.x); h0[2] = bflo(r.y); h0[3] = bfhi(r.y); h1[0] = bflo(r.z); h1[1] = bfhi(r.z); h1[2] = bflo(r.w); h1[3] = bfhi(r.w);
                        h0 += acc[ai][bj][m][0]; h1 += acc[ai][bj][m][1];
                        ssum += ((h0[0] * h0[0] + h0[1] * h0[1]) + (h0[2] * h0[2] + h0[3] * h0[3])) + ((h1[0] * h1[0] + h1[1] * h1[1]) + (h1[2] * h1[2] + h1[3] * h1[3]));
                        u32x4 w; w.x = cvt_pk_bf16(h0[0], h0[1]); w.y = cvt_pk_bf16(h0[2], h0[3]); w.z = cvt_pk_bf16(h1[0], h1[1]); w.w = cvt_pk_bf16(h1[2], h1[3]);
                        *(u32x4*)(HB + (size_t)row * 4096 + col0 + bj * HALF) = w; }
                    ssum += __shfl_xor(ssum, 16); ssum += __shfl_xor(ssum, 32);
                    if (fq == 0) PARTM[(size_t)(u.pn * 4 + wc) * 16384 + row] = ssum; }
            }
            __builtin_amdgcn_sched_barrier(0);
        }
    }
};
struct PoolOrder : StaticOrder {
    __host__ __device__ bool next(int i, Unit& u) const { if (!StaticOrder::next(i, u)) return false; u.aoff = (unsigned)(u.pn >> 1) * 1024u; return true; }
};

template <class Epi, class Sched, bool ALIGN_EPI = false, bool SP2 = false>
__device__ __forceinline__ void gemm_phase(PG8_LAS unsigned char* lds, const Gemm g, const Sched& S, const Epi& E) {
    int tid = threadIdx.x; asm volatile("" : "+v"(tid));
    const int wid = __builtin_amdgcn_readfirstlane(tid >> 6), lane = tid & 63, wr = wid >> 2, wc = wid & 3, fr = lane & 15, fq = lane >> 4;
    const int K = g.K, nt = K / BK;
    unsigned voffA[2], voffB[2];
#pragma unroll
    for (int i = 0; i < 2; ++i) { int R, C; stage_rc(tid * 16 + i * 8192, R, C); const int Rb = Epi::PERM ? ((R & ~31) + perm32(R & 31)) : R;
        voffA[i] = (unsigned)(R * g.lda + C) * 2u; voffB[i] = (unsigned)(Rb * g.ldb + C) * 2u; }
    const size_t kstep = (size_t)(BK * 2);
    const size_t hstepA = (size_t)HALF * g.lda * 2, hstepB = (size_t)HALF * g.ldb * 2;
    const size_t tstepA = 2 * hstepA, tstepB = 2 * hstepB;
    const unsigned ldsw = (unsigned)wid * 1024u;
    const int aoff = lds_byte(wr * 64 + fr, fq * 8), boff = lds_byte(wc * 32 + fr, fq * 8);
#define PG8_SA(b, h) (((b) * 2 + (h)) * HTB)
#define PG8_SB(b, h) ((4 + (b) * 2 + (h)) * HTB)
#define PG8_STAGE(bufoff, gbase, voff) do { _Pragma("unroll") for (int _i = 0; _i < 2; ++_i) \
        __builtin_amdgcn_global_load_lds((const unsigned*)((const char*)(gbase) + (voff)[_i]), (PG8_LAS unsigned*)(lds + (bufoff) + ldsw + _i * 8192), 16, 0, 0); } while (0)
#define PG8_LDA(dst, b, h) do { _Pragma("unroll") for (int m = 0; m < 4; ++m) _Pragma("unroll") for (int k = 0; k < 2; ++k) dst[m][k] = *(const PG8_LAS bf16x8*)(lds + PG8_SA(b, h) + aoff + m * 2048 + k * 1024); } while (0)
#define PG8_LDB(dst, b, h) do { _Pragma("unroll") for (int n = 0; n < 2; ++n) _Pragma("unroll") for (int k = 0; k < 2; ++k) dst[n][k] = *(const PG8_LAS bf16x8*)(lds + PG8_SB(b, h) + boff + n * 2048 + k * 1024); } while (0)
#define PG8_MMA(ai, bj, At, Bt) do { __builtin_amdgcn_s_setprio(1); _Pragma("unroll") for (int m = 0; m < 4; ++m) _Pragma("unroll") for (int n = 0; n < 2; ++n) _Pragma("unroll") for (int k = 0; k < 2; ++k) \
        acc[ai][bj][m][n] = __builtin_amdgcn_mfma_f32_16x16x32_bf16(Bt[n][k], At[m][k], acc[ai][bj][m][n], 0, 0, 0); __builtin_amdgcn_s_setprio(0); } while (0)
#define PG8_WAIT_V(n) asm volatile("s_waitcnt vmcnt(" #n ")" ::: "memory")
#define PG8_WAIT_L(n) asm volatile("s_waitcnt lgkmcnt(" #n ")" ::: "memory")
#define PG8_BAR __builtin_amdgcn_s_barrier()
#define PG8_SCHED __builtin_amdgcn_sched_barrier(0)
    Unit cur, nxt; int ui = 0;
    if (!S.next(0, cur)) return;
    f32x4 acc[2][2][4][2];
#pragma unroll
    for (int a = 0; a < 2; ++a)
#pragma unroll
        for (int b = 0; b < 2; ++b)
#pragma unroll
            for (int m = 0; m < 4; ++m)
#pragma unroll
                for (int n = 0; n < 2; ++n) acc[a][b][m][n] = (f32x4){0.f, 0.f, 0.f, 0.f};
    bf16x8 At[4][2], B0[2][2], B1[2][2];
    const char* cA = (const char*)g.A + (size_t)cur.pm * tstepA + cur.aoff; const char* cB = (const char*)g.Bt + (size_t)cur.pn * tstepB;
    S.a_ready(cur);
    if constexpr (SP2) {
        PG8_STAGE(PG8_SB(0, 0), cB, voffB); PG8_STAGE(PG8_SB(0, 1), cB + hstepB, voffB); PG8_STAGE(PG8_SA(0, 0), cA, voffA); PG8_STAGE(PG8_SA(0, 1), cA + hstepA, voffA);
        if (wr == 1) PG8_BAR;
        PG8_WAIT_V(2); PG8_BAR;
        PG8_STAGE(PG8_SB(1, 0), cB + kstep, voffB); PG8_STAGE(PG8_SA(1, 0), cA + kstep, voffA); PG8_STAGE(PG8_SB(1, 1), cB + hstepB + kstep, voffB);
        PG8_WAIT_V(6); PG8_BAR;
    } else {
        PG8_STAGE(PG8_SB(0, 0), cB, voffB); PG8_STAGE(PG8_SA(0, 0), cA, voffA); PG8_STAGE(PG8_SB(0, 1), cB + hstepB, voffB); PG8_STAGE(PG8_SA(0, 1), cA + hstepA, voffA);
        if (wr == 1) PG8_BAR;
        PG8_WAIT_V(4); PG8_BAR;
        PG8_STAGE(PG8_SB(1, 0), cB + kstep, voffB); PG8_STAGE(PG8_SA(1, 0), cA + kstep, voffA); PG8_STAGE(PG8_SB(1, 1), cB + hstepB + kstep, voffB);
        PG8_WAIT_V(6); PG8_BAR;
    }
    for (;;) {
        const bool has_next = S.next(ui + 1, nxt);
        const char* nA = has_next ? (const char*)g.A + (size_t)nxt.pm * tstepA + nxt.aoff : cA; const char* nB = has_next ? (const char*)g.Bt + (size_t)nxt.pn * tstepB : cB;
        for (int t = 0; t < nt; t += 2) {
            const bool last = (t == nt - 2);
            if constexpr (Epi::MID) { if (t == (nt >> 1)) E.mid(acc, cur, wr, wc, fr, fq); }
            const char* a1 = cA + (size_t)(t + 1) * kstep;
            const char* a2 = last ? nA : cA + (size_t)(t + 2) * kstep; const char* b2 = last ? nB : cB + (size_t)(t + 2) * kstep;
            const char* a3 = a2 + kstep; const char* b3 = b2 + kstep;
            if (last && has_next) S.a_ready(nxt);
            if constexpr (SP2) {
            PG8_LDB(B0, 0, 0); PG8_LDB(B1, 0, 1); PG8_SCHED; PG8_LDA(At, 0, 0); PG8_STAGE(PG8_SA(1, 1), a1 + hstepA, voffA);
            PG8_WAIT_V(8); PG8_WAIT_L(0); PG8_BAR; PG8_MMA(0, 0, At, B0); PG8_MMA(0, 1, At, B1); PG8_BAR; PG8_SCHED;
            PG8_LDA(At, 0, 1); PG8_STAGE(PG8_SB(0, 0), b2, voffB); PG8_STAGE(PG8_SB(0, 1), b2 + hstepB, voffB); PG8_STAGE(PG8_SA(0, 0), a2, voffA);
            PG8_WAIT_V(8); PG8_WAIT_L(0); PG8_BAR; PG8_MMA(1, 0, At, B0); PG8_MMA(1, 1, At, B1); PG8_BAR; PG8_SCHED;
            PG8_LDB(B0, 1, 0); PG8_LDB(B1, 1, 1); PG8_SCHED; PG8_LDA(At, 1, 0); PG8_STAGE(PG8_SA(0, 1), a2 + hstepA, voffA);
            PG8_WAIT_V(8); PG8_WAIT_L(0); PG8_BAR; PG8_MMA(0, 0, At, B0); PG8_MMA(0, 1, At, B1); PG8_BAR; PG8_SCHED;
            PG8_LDA(At, 1, 1); PG8_STAGE(PG8_SB(1, 0), b3, voffB); PG8_STAGE(PG8_SB(1, 1), b3 + hstepB, voffB); PG8_STAGE(PG8_SA(1, 0), a3, voffA);
            PG8_WAIT_V(8); PG8_WAIT_L(0); PG8_BAR; PG8_MMA(1, 0, At, B0); PG8_MMA(1, 1, At, B1); PG8_BAR; PG8_SCHED;
            } else {
            PG8_LDB(B0, 0, 0); PG8_SCHED; PG8_LDA(At, 0, 0); PG8_STAGE(PG8_SA(1, 1), a1 + hstepA, voffA);
            PG8_WAIT_L(8); PG8_BAR; PG8_WAIT_L(0); PG8_MMA(0, 0, At, B0); PG8_BAR; PG8_SCHED;
            PG8_LDB(B1, 0, 1); PG8_STAGE(PG8_SB(0, 0), b2, voffB);
            PG8_BAR; PG8_WAIT_L(0); PG8_MMA(0, 1, At, B1); PG8_BAR;
            PG8_LDA(At, 0, 1); PG8_STAGE(PG8_SA(0, 0), a2, voffA);
            PG8_BAR; PG8_WAIT_L(0); PG8_MMA(1, 0, At, B0); PG8_BAR; PG8_SCHED;
            PG8_STAGE(PG8_SB(0, 1), b2 + hstepB, voffB);
            PG8_WAIT_V(6); PG8_BAR; PG8_MMA(1, 1, At, B1); PG8_BAR;
            PG8_LDB(B0, 1, 0); PG8_SCHED; PG8_LDA(At, 1, 0); PG8_STAGE(PG8_SA(0, 1), a2 + hstepA, voffA);
            PG8_WAIT_L(8); PG8_BAR; PG8_WAIT_L(0); PG8_MMA(0, 0, At, B0); PG8_BAR; PG8_SCHED;
            PG8_LDB(B1, 1, 1); PG8_STAGE(PG8_SB(1, 0), b3, voffB);
            PG8_BAR; PG8_WAIT_L(0); PG8_MMA(0, 1, At, B1); PG8_BAR;
            PG8_LDA(At, 1, 1); PG8_STAGE(PG8_SA(1, 0), a3, voffA);
            PG8_BAR; PG8_WAIT_L(0); PG8_MMA(1, 0, At, B0); PG8_BAR; PG8_SCHED;
            PG8_STAGE(PG8_SB(1, 1), b3 + hstepB, voffB);
            PG8_WAIT_V(6); PG8_BAR; PG8_MMA(1, 1, At, B1); PG8_BAR;
            }
        }
        if constexpr (ALIGN_EPI) { if (wr == 0) PG8_BAR; }
#ifdef TPROBE_SEL
        unsigned te0_ = 0; if constexpr (Epi::TAG == TPROBE_SEL) te0_ = (unsigned)__builtin_amdgcn_s_memrealtime();
#endif
        if constexpr (!Epi::AFTER_DRAIN) { E(acc, cur, wr, wc, fr, fq); S.done(cur); }
#ifdef TPROBE_SEL
        if constexpr (Epi::TAG == TPROBE_SEL) if (tid == 0) { asm volatile("s_waitcnt vmcnt(0)" ::: "memory"); ((volatile PG8_LAS unsigned*)(lds + 131072 + 320))[16 + Epi::TAG] += (unsigned)__builtin_amdgcn_s_memrealtime() - te0_; }
#endif
        if (!has_next) break;
#pragma unroll
        for (int a = 0; a < 2; ++a)
#pragma unroll
            for (int b = 0; b < 2; ++b)
#pragma unroll
                for (int m = 0; m < 4; ++m)
#pragma unroll
                    for (int n = 0; n < 2; ++n) acc[a][b][m][n] = (f32x4){0.f, 0.f, 0.f, 0.f};
        cur = nxt; cA = nA; cB = nB; ++ui;
        if constexpr (ALIGN_EPI) { if (wr == 1) PG8_BAR; }
    }
    PG8_WAIT_V(0);
    if constexpr (!ALIGN_EPI) { if (wr == 0) PG8_BAR; }
    PG8_BAR;
    if constexpr (Epi::AFTER_DRAIN) { E.fused(acc, cur, wr, wc, fr, fq, lds, wid, lane); S.done(cur); }
#undef PG8_SA
#undef PG8_SB
#undef PG8_STAGE
#undef PG8_LDA
#undef PG8_LDB
#undef PG8_MMA
#undef PG8_WAIT_V
#undef PG8_WAIT_L
#undef PG8_BAR
#undef PG8_SCHED
}
}
#ifndef DBLMASK
#define DBLMASK 0
#endif
#ifndef PG8_SP2
#define PG8_SP2 true
#endif
#ifndef PG8_ALIGN
#define PG8_ALIGN true
#endif

constexpr int NWAVES = 8;
constexpr int D_MODEL = 4096, BATCH = 4, SEQ = 4096, DEPTH = 4, N_META = 16, LSEQ = N_META + SEQ  ;
constexpr int MMAIN = BATCH * SEQ  , NMETA_ROWS = BATCH * N_META  , MP = MMAIN + NMETA_ROWS  , MPA = MMAIN + 256  ;
constexpr int HEADS = 16, NOPE = 128, ROPE = 64, QKD = 192, VD = 128, MLAW = 2048, QLORA = 1024, KVLORA = 512, POOLW = 2048;
constexpr int IN_WIDTH = 15936, NIN = 16128;
constexpr int PC_CQ = 0, PC_CKV = 1024, PC_U = 1536, PC_GA = 3584, PC_GB = 5632, PC_MA = 7680, PC_MB = 11776, PC_KR = 15872;
constexpr int LP = 4160;
constexpr float NORM_EPS = 1e-6f;

constexpr size_t al256(size_t x) { return (x + 255) / 256 * 256; }
constexpr size_t WS_CTL = 0, CTL_ZERO_BYTES = 1u << 20;
constexpr size_t WS_TAB = CTL_ZERO_BYTES;
constexpr size_t WS_W = WS_TAB + al256((size_t)LSEQ * 32 * 8);
constexpr size_t WL_IN = 0, WL_UQ = WL_IN + (size_t)NIN * 4096 * 2, WL_UKV = WL_UQ + (size_t)3072 * 1024 * 2, WL_POOL = WL_UKV + (size_t)4096 * 512 * 2,
                 WL_AB = WL_POOL + (size_t)2048 * 512 * 2, WL_OUT = WL_AB + (size_t)4096 * 4096 * 2, WL_SIZE = WL_OUT + (size_t)4096 * 4096 * 2;
constexpr size_t WS_SS = WS_W + DEPTH * WL_SIZE;
constexpr size_t WS_PART = WS_SS + al256((size_t)2 * MPA * 4);
constexpr size_t WS_PARTM = WS_PART + 64 * 256 * 4;
constexpr size_t WS_H = WS_PARTM + (size_t)64 * 16384 * 4;
constexpr size_t WS_HN = WS_H + (size_t)MPA * 4096 * 4;
constexpr size_t WS_PROJ = WS_HN + (size_t)MPA * 4096 * 2;
constexpr size_t WS_PARTQ = WS_PROJ + (size_t)MPA * NIN * 2;
constexpr size_t WS_SSQ = WS_PARTQ + (size_t)24 * MPA * 4;
constexpr size_t WS_CKVN = WS_SSQ + (size_t)2 * MPA * 4;
constexpr size_t WS_DIFF = WS_CKVN + (size_t)MP * 512 * 2;
constexpr size_t WS_QRAW = WS_DIFF + (size_t)MP * 2048 * 2;
constexpr size_t WS_KRAW = WS_QRAW + (size_t)MP * 3072 * 2;
constexpr size_t WS_KA = WS_KRAW + (size_t)MP * 2048 * 2;
constexpr size_t WS_VA = WS_KA + (size_t)64 * LP * 192 * 2;
constexpr size_t WS_XAB = WS_VA + (size_t)64 * LP * 128 * 2;
constexpr size_t WS_T1 = WS_XAB + (size_t)MP * 4096 * 2;
constexpr size_t WS_MG = WS_T1 + (size_t)MP * 4096 * 2;
constexpr size_t WS_END = WS_MG + (size_t)MP * 4096 * 2 + 65536;
constexpr int CW_TMO = 0, CW_BAR = 4096, CW_ARR = 8192;

constexpr int RING_OFF = 0, RING_BYTES = 131072, LDSCTL_OFF = RING_BYTES, MISC_OFF = LDSCTL_OFF + 320, LDS_BYTES = 147456;

#define GAS __attribute__((address_space(1)))
#define LAS __attribute__((address_space(3)))
typedef unsigned short bf16;
typedef unsigned v4u __attribute__((ext_vector_type(4)));
typedef unsigned v2u __attribute__((ext_vector_type(2)));
typedef float f32x4 __attribute__((ext_vector_type(4)));
typedef short bf16x8 __attribute__((ext_vector_type(8)));
typedef short s16x4 __attribute__((ext_vector_type(4)));
typedef float f32x16 __attribute__((ext_vector_type(16)));
#define LDS_WAIT() asm volatile("s_waitcnt lgkmcnt(0)" ::: "memory")
#define VM_WAIT() asm volatile("s_waitcnt vmcnt(0)" ::: "memory")
#define WG_BAR() do { asm volatile("s_waitcnt lgkmcnt(0)" ::: "memory"); __builtin_amdgcn_s_barrier(); asm volatile("" ::: "memory"); } while (0)
__device__ __forceinline__ unsigned cvtpk(float lo, float hi) { unsigned r; asm volatile("v_cvt_pk_bf16_f32 %0, %1, %2" : "=v"(r) : "v"(lo), "v"(hi)); return r; }
__device__ __forceinline__ float bflo(unsigned u) { return __uint_as_float(u << 16); }
__device__ __forceinline__ float bfhi(unsigned u) { return __uint_as_float(u & 0xffff0000u); }
__device__ __forceinline__ float wave_sum(float v) {
#pragma unroll
    for (int o = 1; o < 64; o <<= 1) v += __shfl_xor(v, o);
    return v;
}

__device__ __forceinline__ void row_bp(int m, int& b, int& pos) { if (m < MMAIN) { b = m >> 12; pos = N_META + (m & 4095); } else { const int j = m - MMAIN; b = j >> 4; pos = j & 15; } }
__device__ __forceinline__ int row_of(int b, int pos) { return pos >= N_META ? b * SEQ + pos - N_META : MMAIN + b * N_META + pos; }

#define XB_TMO      128
#define XB_XCNT(j)  (256  + 64 * (j))
#define XB_XSUB(j)  (1280 + 64 * (j))
#define XB_XGEN(j)  (2304 + 64 * (j))
#define XB_TOP      3328
#define XB_TOPGEN   3392
#define XCD_BAR_WORDS 3456
#define XB_SPIN_CAP (1u << 18)
__device__ __forceinline__ unsigned xb_ld(unsigned* p)              { return __hip_atomic_load(p, __ATOMIC_RELAXED, __HIP_MEMORY_SCOPE_AGENT); }
__device__ __forceinline__ unsigned xb_add(unsigned* p, unsigned v) { return __hip_atomic_fetch_add(p, v, __ATOMIC_RELAXED, __HIP_MEMORY_SCOPE_AGENT); }
__device__ __forceinline__ unsigned xb_xcc_id() { return (unsigned)__builtin_amdgcn_s_getreg((3 << 11) | 20) & 0xFu; }
#define XB_SPIN(cond, bar) do { unsigned _sp = 0; while (cond) { __builtin_amdgcn_s_sleep(1); \
    if ((++_sp & 255u) == 0u) { if (xb_ld(&(bar)[XB_TMO])) break; if (_sp > XB_SPIN_CAP) { atomicAdd(&(bar)[XB_TMO], 1u); break; } } } } while (0)
struct XcdBarrier { unsigned* bar; unsigned x; volatile LAS unsigned* st; };
__device__ __forceinline__ XcdBarrier xcd_barrier_post(unsigned* bar, volatile LAS unsigned* st) {
    XcdBarrier b; b.bar = bar; b.x = xb_xcc_id(); b.st = st;
    if (threadIdx.x == 0) (void)xb_add(&bar[XB_XCNT(b.x)], 1u);
    return b;
}
__device__ __forceinline__ void xcd_barrier_complete(unsigned* bar, unsigned x, unsigned& nloc, unsigned& nx) {
    const unsigned G = gridDim.x * gridDim.y * gridDim.z;
    unsigned sum, cnt, mine, sp = 0u;
    for (;;) {
        sum = 0u; cnt = 0u; mine = 0u;
#pragma unroll
        for (unsigned j = 0; j < 16; ++j) { const unsigned c = xb_ld(&bar[XB_XCNT(j)]); sum += c; cnt += (c > 0u) ? 1u : 0u; mine = (j == x) ? c : mine; }
        if (sum == G) break;
        __builtin_amdgcn_s_sleep(1);
        if ((++sp & 255u) == 0u) { if (xb_ld(&bar[XB_TMO])) break; if (sp > XB_SPIN_CAP) { atomicAdd(&bar[XB_TMO], 1u); break; } }
    }
    nloc = mine > 0u ? mine : 1u; nx = cnt > 0u ? cnt : 1u;
}
__device__ __forceinline__ void xcd_barrier(const XcdBarrier& b) {
    asm volatile("s_waitcnt vmcnt(0)" ::: "memory");
    __syncthreads();
    if (threadIdx.x == 0) {
        unsigned* bar = b.bar;
        const unsigned bx = xb_xcc_id();
        __builtin_amdgcn_s_waitcnt(0);
        unsigned nloc = b.st[0], nx = b.st[1];
        if (nloc == 0u) { xcd_barrier_complete(bar, bx, nloc, nx); b.st[0] = nloc; b.st[1] = nx; }
        const unsigned old = xb_add(&bar[XB_XSUB(bx)], 1u);
        const unsigned gen = old / nloc;
        if (old + 1u == (gen + 1u) * nloc) {
            __builtin_amdgcn_fence(__ATOMIC_RELEASE, "agent");
            asm volatile("s_waitcnt vmcnt(0)" ::: "memory");
            const unsigned og = xb_add(&bar[XB_TOP], 1u);
            const unsigned tg = og / nx;
            if (og + 1u == (tg + 1u) * nx) xb_add(&bar[XB_TOPGEN], 1u);
            else XB_SPIN(xb_ld(&bar[XB_TOPGEN]) == tg, bar);
            __builtin_amdgcn_fence(__ATOMIC_ACQUIRE, "agent");
            xb_add(&bar[XB_XGEN(bx)], 1u);
            asm volatile("s_waitcnt vmcnt(0)" ::: "memory");
        } else {
            XB_SPIN(xb_ld(&bar[XB_XGEN(bx)]) == gen, bar);
            __builtin_amdgcn_fence(__ATOMIC_ACQUIRE, "agent");
            asm volatile("s_waitcnt vmcnt(0)" ::: "memory");
        }
    }
    __syncthreads();
}

struct Frame {
    LAS unsigned char* lds;
    int tid, lane, wave, vcu, G;
    unsigned char* ws;
    const float* in[15];
    float* out;
};
enum { I_X = 0, I_META, I_NORMG, I_WIN, I_QLG, I_KVLG, I_WUQ, I_WUKV, I_QHG, I_KHG, I_WPOOL, I_PSCALE, I_WA, I_WB, I_WOUT };

__device__ __forceinline__ void tr_item(const float* W, int ldw, int k0, int nsrc0, bf16* WT, int ldt, int ndst0, int kdst0, LAS float* scr, int lane, const float* ks = nullptr) {
#pragma unroll 8
    for (int i = 0; i < 32; ++i) { const int kk = 2 * i + (lane >> 5); scr[kk * 33 + (lane & 31)] = W[(size_t)(k0 + kk) * ldw + nsrc0 + (lane & 31)]; }
    const int c = lane & 7;
    f32x4 sa = {1.f, 1.f, 1.f, 1.f}, sb = sa; if (ks) { sa = *(const GAS f32x4*)(ks + k0 + 8 * c); sb = *(const GAS f32x4*)(ks + k0 + 8 * c + 4); }
    LDS_WAIT(); asm volatile("" ::: "memory");
#pragma unroll
    for (int j = 0; j < 4; ++j) { const int n = (lane >> 3) + 8 * j; const LAS float* s = scr + (8 * c) * 33 + n;
        v4u o; o.x = cvtpk(s[0 * 33] * sa.x, s[1 * 33] * sa.y); o.y = cvtpk(s[2 * 33] * sa.z, s[3 * 33] * sa.w); o.z = cvtpk(s[4 * 33] * sb.x, s[5 * 33] * sb.y); o.w = cvtpk(s[6 * 33] * sb.z, s[7 * 33] * sb.w);
        *(GAS v4u*)(WT + (size_t)(ndst0 + n) * ldt + kdst0 + k0 + 8 * c) = o; }
    LDS_WAIT(); asm volatile("" ::: "memory");
}
constexpr int IT_IN = 64 * (NIN / 32), IT_UQ = 16 * 96, IT_UKV = 8 * 128, IT_POOL = 4 * 8 * 16, IT_A = 32 * 128, IT_B = 32 * 128, IT_OUT = 64 * 128;
constexpr int IT_LAYER = IT_IN + IT_UQ + IT_UKV + IT_POOL + IT_A + IT_B + IT_OUT;
__device__ __forceinline__ void p0_prologue(Frame& F0) {
    struct { LAS unsigned char* lds; int tid, lane, wave, vcu, G; unsigned char* ws; const float* const* in; } F;
    F.lds = F0.lds; F.tid = F0.tid; asm volatile("" : "+v"(F.tid)); F.lane = F.tid & 63; F.wave = F0.wave; F.vcu = F0.vcu; F.G = F0.G; F.ws = F0.ws; F.in = F0.in;
    LAS float* scr = (LAS float*)(F.lds + RING_OFF + F.wave * 16384);
    const int gw = F.vcu * NWAVES + F.wave, NGW = F.G * NWAVES;
    for (int it = gw; it < DEPTH * IT_LAYER; it += NGW) {
        const int l = it / IT_LAYER; int r = it - l * IT_LAYER;
        bf16* wl = (bf16*)(F.ws + WS_W + (size_t)l * WL_SIZE);
        if (r < IT_IN) { const int kb = r / (NIN / 32), nb = r - kb * (NIN / 32), nd = nb * 32, k0 = kb * 64;
            bf16* WT = (bf16*)((unsigned char*)wl + WL_IN);
            if (nd >= IN_WIDTH) {
#pragma unroll
                for (int j = 0; j < 4; ++j) { const int q = j * 64 + F.lane, n = q >> 3, c = q & 7; *(GAS v4u*)(WT + (size_t)(nd + n) * 4096 + k0 + 8 * c) = (v4u){0u, 0u, 0u, 0u}; }
            } else { int ns;
                if (nd < 1536) ns = nd; else if (nd < PC_MA) ns = nd + 64; else if (nd < PC_KR) { const int rel = nd - PC_MA, t = rel >> 8, off = rel & 255; ns = (off < 128 ? 7744 : 11840) + 128 * t + (off & 127); } else ns = nd - PC_KR + 1536;
                tr_item(F.in[I_WIN] + (size_t)l * 4096 * IN_WIDTH, IN_WIDTH, k0, ns, WT, 4096, nd, 0, scr, F.lane, F.in[I_NORMG] + (size_t)l * 4096); }
            continue; }
        r -= IT_IN;
        if (r < IT_UQ) { const int kb = r / 96, nb = r - kb * 96; tr_item(F.in[I_WUQ] + (size_t)l * 1024 * 3072, 3072, kb * 64, nb * 32, (bf16*)((unsigned char*)wl + WL_UQ), 1024, nb * 32, 0, scr, F.lane, F.in[I_QLG] + (size_t)l * 1024); continue; }
        r -= IT_UQ;
        if (r < IT_UKV) { const int kb = r / 128, nb = r - kb * 128; tr_item(F.in[I_WUKV] + (size_t)l * 512 * 4096, 4096, kb * 64, nb * 32, (bf16*)((unsigned char*)wl + WL_UKV), 512, nb * 32, 0, scr, F.lane, F.in[I_KVLG] + (size_t)l * 512); continue; }
        r -= IT_UKV;
        if (r < IT_POOL) { const int g = r / 128, rr = r - g * 128, kb = rr / 16, nb = rr - kb * 16;
            tr_item(F.in[I_WPOOL] + ((size_t)l * 4 + g) * 512 * 512, 512, kb * 64, nb * 32, (bf16*)((unsigned char*)wl + WL_POOL), 512, g * 512 + nb * 32, 0, scr, F.lane); continue; }
        r -= IT_POOL;
        if (r < IT_A) { const int kb = r / 128, nb = r - kb * 128; tr_item(F.in[I_WA] + (size_t)l * 2048 * 4096, 4096, kb * 64, nb * 32, (bf16*)((unsigned char*)wl + WL_AB), 4096, nb * 32, 0, scr, F.lane); continue; }
        r -= IT_A;
        if (r < IT_B) { const int kb = r / 128, nb = r - kb * 128; tr_item(F.in[I_WB] + (size_t)l * 2048 * 4096, 4096, kb * 64, nb * 32, (bf16*)((unsigned char*)wl + WL_AB), 4096, nb * 32, 2048, scr, F.lane); continue; }
        r -= IT_B;
        { const int kb = r / 128, nb = r - kb * 128; tr_item(F.in[I_WOUT] + (size_t)l * 4096 * 4096, 4096, kb * 64, nb * 32, (bf16*)((unsigned char*)wl + WL_OUT), 4096, nb * 32, 0, scr, F.lane); }
    }
    const size_t gt = (size_t)(F.vcu) * (NWAVES * 64) + F.tid, NT = (size_t)F.G * NWAVES * 64;
    { bf16* HG = (bf16*)(F.ws + WS_HN); float* SS = (float*)(F.ws + WS_SS);
      for (int m = gw; m < MP; m += NGW) {
          const float* src = m < MMAIN ? F.in[I_X] + (size_t)m * 4096 : F.in[I_META] + (size_t)((m - MMAIN) & 15) * 4096;
          const GAS f32x4* xr = (const GAS f32x4*)src + F.lane; GAS v2u* o = (GAS v2u*)(HG + (size_t)m * 4096) + F.lane;
          float ss = 0.f;
#pragma unroll 4
          for (int j = 0; j < 16; ++j) { const f32x4 v = xr[64 * j]; ss += (v.x * v.x + v.y * v.y) + (v.z * v.z + v.w * v.w);
              v2u w; w.x = cvtpk(v.x, v.y); w.y = cvtpk(v.z, v.w); o[64 * j] = w; }
          ss = wave_sum(ss); if (F.lane == 0) SS[m] = ss; } }
    { float* TAB = (float*)(F.ws + WS_TAB);
      for (size_t i = gt; i < (size_t)LSEQ * 32; i += NT) { const int pos = (int)(i >> 5), fi = (int)(i & 31);
          const float inv = 1.0f / powf(10000.0f, (float)fi * (1.0f / 32.0f)); const float ang = (float)pos * inv;
          double rev = (double)ang * 0.15915494309189533577; rev -= rint(rev); const float rv = (float)rev;
          TAB[2 * i] = __builtin_amdgcn_cosf(rv); TAB[2 * i + 1] = __builtin_amdgcn_sinf(rv); } }
    { bf16* KA = (bf16*)(F.ws + WS_KA); bf16* VA = (bf16*)(F.ws + WS_VA);
      for (size_t i = gt; i < (size_t)64 * 48 * 24; i += NT) { const int bh = (int)(i / (48 * 24)), rr = (int)(i % (48 * 24)); *(GAS v4u*)(KA + ((size_t)bh * LP + 16) * 192 + rr * 8) = (v4u){0u, 0u, 0u, 0u}; }
      for (size_t i = gt; i < (size_t)64 * 48 * 16; i += NT) { const int bh = (int)(i / (48 * 16)), rr = (int)(i % (48 * 16)); *(GAS v4u*)(VA + ((size_t)bh * LP + 16) * 128 + rr * 8) = (v4u){0u, 0u, 0u, 0u}; } }
}

__device__ __forceinline__ void unpack8(const v4u& u, float (&f)[8]) { f[0] = bflo(u.x); f[1] = bfhi(u.x); f[2] = bflo(u.y); f[3] = bfhi(u.y); f[4] = bflo(u.z); f[5] = bfhi(u.z); f[6] = bflo(u.w); f[7] = bfhi(u.w); }
constexpr int P3_RUNL = 9, P3_NRUN = (LSEQ + P3_RUNL - 1) / P3_RUNL;
template <int J> __device__ __forceinline__ void p3_load(const bf16* PROJ, int b, int p0, int lane, v4u (&r)[(2 << J) - 1 + P3_RUNL]) {
    constexpr int W = 2 << J, NR = W - 1 + P3_RUNL; const int c = (J * 64 + lane) * 8;
#pragma unroll
    for (int i = 0; i < NR; ++i) { int pos = p0 - (W - 1) + i; pos = pos < 0 ? 0 : (pos > LSEQ - 1 ? LSEQ - 1 : pos); r[i] = *(const GAS v4u*)(PROJ + (size_t)row_of(b, pos) * NIN + PC_U + c); }
}
template <int J> __device__ __forceinline__ void p3_slide(bf16* DIFF, int b, int p0, int lane, const v4u (&r)[(2 << J) - 1 + P3_RUNL]) {
    constexpr int W = 2 << J; const int c = (J * 64 + lane) * 8;
    float S[8];
#pragma unroll
    for (int e = 0; e < 8; ++e) S[e] = 0.f;
#pragma unroll
    for (int i = 0; i < W - 1; ++i) { float t[8]; unpack8(r[i], t); const float keep = p0 - (W - 1) + i >= 0 ? 1.0f : 0.0f;
#pragma unroll
        for (int e = 0; e < 8; ++e) S[e] += keep * t[e]; }
#pragma unroll
    for (int q = 0; q < P3_RUNL; ++q) { const int p = p0 + q; float x[8], t[8], d[8]; unpack8(r[W - 1 + q], x); unpack8(r[q], t);
        const int n = p + 1 < W ? p + 1 : W; const float rn = 1.0f / (float)n; const float drop = (p - W + 1 >= 0) ? 1.0f : 0.0f;
#pragma unroll
        for (int e = 0; e < 8; ++e) { S[e] += x[e]; d[e] = S[e] * rn - x[e]; S[e] -= drop * t[e]; }
        v4u o; o.x = cvtpk(d[0], d[1]); o.y = cvtpk(d[2], d[3]); o.z = cvtpk(d[4], d[5]); o.w = cvtpk(d[6], d[7]);
        if (p < LSEQ) *(GAS v4u*)(DIFF + (size_t)row_of(b, p) * 2048 + c) = o; }
}
__device__ __forceinline__ void p3_latent(Frame& F0, const float* qg, const float* kvg, float* ssn) {
    struct { int lane, wave, vcu, G; unsigned char* ws; } F; F.lane = F0.lane; asm volatile("" : "+v"(F.lane)); F.wave = F0.wave; F.vcu = F0.vcu; F.G = F0.G; F.ws = F0.ws;
    const bf16* PROJ = (const bf16*)(F.ws + WS_PROJ); bf16* DIFF = (bf16*)(F.ws + WS_DIFF);
    if (F.wave == NWAVES - 1) { const float* PARTQ = (const float*)(F.ws + WS_PARTQ); float* SSQ = (float*)(F.ws + WS_SSQ);
      for (int i = F.lane; i < 65; i += 64) { const int m = F.vcu * 65 + i; if (m < MP) { float v[24];
#pragma unroll
          for (int k = 0; k < 24; ++k) v[k] = PARTQ[(size_t)k * MPA + m];
          float sq = 0.f, skv = 0.f;
#pragma unroll
          for (int k = 0; k < 16; ++k) sq += v[k];
#pragma unroll
          for (int k = 16; k < 24; ++k) skv += v[k];
          SSQ[m] = sq; SSQ[MPA + m] = skv; } } }
    for (int run = F.wave * F.G + F.vcu; run < BATCH * P3_NRUN; run += F.G * NWAVES) {
        const int b = run / P3_NRUN, p0 = (run - b * P3_NRUN) * P3_RUNL;
        { v4u r0[1 + P3_RUNL], r1[3 + P3_RUNL], r2[7 + P3_RUNL];
          p3_load<0>(PROJ, b, p0, F.lane, r0); p3_load<1>(PROJ, b, p0, F.lane, r1); p3_load<2>(PROJ, b, p0, F.lane, r2);
          __builtin_amdgcn_sched_barrier(0);
          p3_slide<0>(DIFF, b, p0, F.lane, r0); p3_slide<1>(DIFF, b, p0, F.lane, r1); p3_slide<2>(DIFF, b, p0, F.lane, r2); }
        __builtin_amdgcn_sched_barrier(0);
        { v4u r3[15 + P3_RUNL];
          p3_load<3>(PROJ, b, p0, F.lane, r3);
          __builtin_amdgcn_sched_barrier(0);
          p3_slide<3>(DIFF, b, p0, F.lane, r3); }
    }
}

__device__ __forceinline__ void p5_knorm(Frame& F0, const float* khg) {
    struct { int lane, wave, vcu, G; unsigned char* ws; } F; F.lane = F0.lane; asm volatile("" : "+v"(F.lane)); F.wave = F0.wave; F.vcu = F0.vcu; F.G = F0.G; F.ws = F0.ws;
    const int gw = F.vcu * NWAVES + F.wave, NGW = F.G * NWAVES;
    const bf16* PROJ = (const bf16*)(F.ws + WS_PROJ); const bf16* KRAW = (const bf16*)(F.ws + WS_KRAW);
    bf16* KA = (bf16*)(F.ws + WS_KA); const float* TAB = (const float*)(F.ws + WS_TAB);
    const int l = F.lane, cn = 8 * (l & 15), hr = l >> 2, c0 = 16 * (l & 3), cp = c0 ^ 32, fi = c0 & 31;
    float gn[8], go[16], gp[16];
#pragma unroll
    for (int e = 0; e < 8; ++e) gn[e] = khg[cn + e];
#pragma unroll
    for (int e = 0; e < 16; ++e) { go[e] = khg[128 + c0 + e]; gp[e] = khg[128 + cp + e]; }
    for (int m = gw; m < MP; m += NGW) {
        int b, pos; row_bp(m, b, pos); const int pp = pos < N_META ? pos : pos + 48;
        const bf16* kr = PROJ + (size_t)m * NIN + PC_KR;
        v4u xr[4], krs, ka0, ka1, kp0, kp1; f32x4 tbv[8];
#pragma unroll
        for (int j = 0; j < 4; ++j) xr[j] = *(const GAS v4u*)(KRAW + (size_t)m * 2048 + 512 * j + 8 * l);
        krs = *(const GAS v4u*)(kr + 8 * (l & 7)); ka0 = *(const GAS v4u*)(kr + c0); ka1 = *(const GAS v4u*)(kr + c0 + 8); kp0 = *(const GAS v4u*)(kr + cp); kp1 = *(const GAS v4u*)(kr + cp + 8);
        { const GAS f32x4* tb = (const GAS f32x4*)(TAB + ((size_t)pos * 32 + fi) * 2);
#pragma unroll
          for (int q = 0; q < 8; ++q) tbv[q] = tb[q]; }
        __builtin_amdgcn_sched_barrier(0);
        float x[4][8], ssn[4];
#pragma unroll
        for (int j = 0; j < 4; ++j) { unpack8(xr[j], x[j]); float sv = 0.f;
#pragma unroll
            for (int e = 0; e < 8; ++e) sv += x[j][e] * x[j][e];
            sv += __shfl_xor(sv, 1); sv += __shfl_xor(sv, 2); sv += __shfl_xor(sv, 4); sv += __shfl_xor(sv, 8); ssn[j] = sv; }
        float sk;
        { float t[8]; unpack8(krs, t); sk = 0.f;
#pragma unroll
          for (int e = 0; e < 8; ++e) sk += t[e] * t[e];
          sk += __shfl_xor(sk, 1); sk += __shfl_xor(sk, 2); sk += __shfl_xor(sk, 4); }
        float r[4];
#pragma unroll
        for (int j = 0; j < 4; ++j) { r[j] = 1.0f / sqrtf((ssn[j] + sk) * (1.0f / 192.0f) + NORM_EPS);
            v4u w; w.x = cvtpk(x[j][0] * r[j] * gn[0], x[j][1] * r[j] * gn[1]); w.y = cvtpk(x[j][2] * r[j] * gn[2], x[j][3] * r[j] * gn[3]);
            w.z = cvtpk(x[j][4] * r[j] * gn[4], x[j][5] * r[j] * gn[5]); w.w = cvtpk(x[j][6] * r[j] * gn[6], x[j][7] * r[j] * gn[7]);
            *(GAS v4u*)(KA + ((size_t)(b * 16 + (l >> 4) + 4 * j) * LP + pp) * 192 + cn) = w; }
        float rr;
        { const int src = 16 * (hr & 3); const float r0 = __shfl(r[0], src), r1 = __shfl(r[1], src), r2 = __shfl(r[2], src), r3 = __shfl(r[3], src); const int jj = hr >> 2;
          rr = jj == 0 ? r0 : (jj == 1 ? r1 : (jj == 2 ? r2 : r3)); }
        float xo[16], xp[16];
        { float t0[8], t1[8]; unpack8(ka0, t0); unpack8(ka1, t1);
#pragma unroll
          for (int e = 0; e < 8; ++e) { xo[e] = t0[e] * rr * go[e]; xo[8 + e] = t1[e] * rr * go[8 + e]; }
          unpack8(kp0, t0); unpack8(kp1, t1);
#pragma unroll
          for (int e = 0; e < 8; ++e) { xp[e] = t0[e] * rr * gp[e]; xp[8 + e] = t1[e] * rr * gp[8 + e]; } }
        const float sgn = (l & 2) ? 1.0f : -1.0f;
        float y[16];
#pragma unroll
        for (int q = 0; q < 8; ++q) { const f32x4 cs = tbv[q]; y[2 * q] = xo[2 * q] * cs.x + sgn * xp[2 * q] * cs.y; y[2 * q + 1] = xo[2 * q + 1] * cs.z + sgn * xp[2 * q + 1] * cs.w; }
        bf16* dst = KA + ((size_t)(b * 16 + hr) * LP + pp) * 192 + 128 + c0;
        v4u w0, w1; w0.x = cvtpk(y[0], y[1]); w0.y = cvtpk(y[2], y[3]); w0.z = cvtpk(y[4], y[5]); w0.w = cvtpk(y[6], y[7]); w1.x = cvtpk(y[8], y[9]); w1.y = cvtpk(y[10], y[11]); w1.z = cvtpk(y[12], y[13]); w1.w = cvtpk(y[14], y[15]);
        *(GAS v4u*)dst = w0; *(GAS v4u*)(dst + 8) = w1;
    }
}

namespace att {
constexpr int KROW = 400, SHM_K = 64 * KROW, SHM_V = 64 * 128 * 2;
constexpr int OFF_V = 0, OFF_K = 2 * SHM_V, OFF_WS = OFF_K + 2 * SHM_K, ATT_LDS = OFF_WS + NWAVES * 64 * 4;
static_assert(ATT_LDS <= RING_BYTES, "attention LDS");
constexpr float SCALE = 0.07216878364870322f;
__device__ __forceinline__ int crow(int r, int hi) { return (r & 3) + 8 * (r >> 2) + 4 * hi; }
__device__ __forceinline__ int v_st(int k, int c) { const int kk = (k & ~0xC) | ((k & 4) << 1) | ((k & 8) >> 1); return ((kk >> 3) * 4 + (c >> 5)) * 512 + ((kk & 7) * 32 + (c & 31)) * 2; }
__device__ __forceinline__ int v_rd_base(int lane) { return ((lane & 3) << 3) | (((lane >> 2) & 3) << 6) | (((lane >> 4) & 1) << 5) | (((lane >> 5) & 1) << 8); }
constexpr int v_rd_off(int d0, int ks, int half) { return d0 * 512 + ks * 4096 + half * 2048; }
template <int OFF> __device__ __forceinline__ s16x4 tr_read(int vb) { s16x4 r; asm volatile("ds_read_b64_tr_b16 %0, %1 offset:%2" : "=&v"(r) : "v"(vb), "i"(OFF) : "memory"); return r; }
template <int D0> __device__ __forceinline__ void pv_reads(int vb, s16x4 (&f)[8]) {
    f[0] = tr_read<v_rd_off(D0, 0, 0)>(vb); f[1] = tr_read<v_rd_off(D0, 0, 1)>(vb); f[2] = tr_read<v_rd_off(D0, 1, 0)>(vb); f[3] = tr_read<v_rd_off(D0, 1, 1)>(vb);
    f[4] = tr_read<v_rd_off(D0, 2, 0)>(vb); f[5] = tr_read<v_rd_off(D0, 2, 1)>(vb); f[6] = tr_read<v_rd_off(D0, 3, 0)>(vb); f[7] = tr_read<v_rd_off(D0, 3, 1)>(vb);
}
__device__ __forceinline__ void pv_mfma(f32x16& od, s16x4 (&f)[8], bf16x8 pa0, bf16x8 pa1, bf16x8 pa2, bf16x8 pa3) {
#pragma unroll
    for (int i = 0; i < 8; ++i) asm volatile("" : "+v"(f[i]));
#define PK(L, H) (bf16x8){L[0], L[1], L[2], L[3], H[0], H[1], H[2], H[3]}
    od = __builtin_amdgcn_mfma_f32_32x32x16_bf16(pa0, PK(f[0], f[1]), od, 0, 0, 0);
    od = __builtin_amdgcn_mfma_f32_32x32x16_bf16(pa1, PK(f[2], f[3]), od, 0, 0, 0);
    od = __builtin_amdgcn_mfma_f32_32x32x16_bf16(pa2, PK(f[4], f[5]), od, 0, 0, 0);
    od = __builtin_amdgcn_mfma_f32_32x32x16_bf16(pa3, PK(f[6], f[7]), od, 0, 0, 0);
#undef PK
}
template <int VAR>
__device__ __forceinline__ void attn_unit(const bf16* Qraw, const float* qhg, const float* TAB, int pos0, const bf16* Kh, const bf16* Vh, int NT, int lw, bf16* XA, const bf16* GA, int m0, int nrows_out, LAS unsigned char* lds) {
    int tid = threadIdx.x; asm volatile("" : "+v"(tid));
    const int wid = __builtin_amdgcn_readfirstlane(tid >> 6), lane = tid & 63, r32 = lane & 31, hi = lane >> 5;
    LAS unsigned char* V_lds = lds + OFF_V; LAS unsigned char* K_lds = lds + OFF_K;
    LAS float* wsf = (LAS float*)(lds + OFF_WS) + wid * 64; LAS float* li_l = wsf; LAS float* al_l = wsf + 32;
    float l_reg = 0.f; f32x16 o[4], negm;
#pragma unroll
    for (int r = 0; r < 16; ++r) negm[r] = 0.f;
#pragma unroll
    for (int d = 0; d < 4; ++d)
#pragma unroll
        for (int r = 0; r < 16; ++r) o[d][r] = 0.f;
    bf16x8 qr[12];
    { const int ri = wid * 32 + r32, rc = ri < nrows_out ? ri : nrows_out - 1;
      const bf16* Qw = Qraw + (size_t)(m0 + rc) * 3072 + hi * 8;
      v4u raw[12]; const int pos = pos0 + rc;
#pragma unroll
      for (int d0 = 0; d0 < 12; ++d0) raw[d0] = *(const GAS v4u*)(Qw + d0 * 16);
      f32x4 tbv[2][4];
#pragma unroll
      for (int dd = 0; dd < 2; ++dd)
#pragma unroll
          for (int q = 0; q < 4; ++q) tbv[dd][q] = *((const GAS f32x4*)(TAB + ((size_t)pos * 32 + dd * 16 + hi * 8) * 2) + q);
      __builtin_amdgcn_sched_barrier(0);
      float ss = 0.f;
#pragma unroll
      for (int d0 = 0; d0 < 12; ++d0) { float t[8]; unpack8(raw[d0], t);
#pragma unroll
          for (int e = 0; e < 8; ++e) ss += t[e] * t[e]; }
      ss += __shfl_xor(ss, 32);
      const float rq = (SCALE * 1.4426950408889634f) / sqrtf(ss * (1.0f / 192.0f) + NORM_EPS);
#pragma unroll
      for (int dh = 0; dh < 2; ++dh) {
          f32x4 g0[4], g1[4];
#pragma unroll
          for (int k = 0; k < 4; ++k) { const int d0 = 4 * dh + k; g0[k] = *(const GAS f32x4*)(qhg + d0 * 16 + hi * 8); g1[k] = *(const GAS f32x4*)(qhg + d0 * 16 + hi * 8 + 4); }
          __builtin_amdgcn_sched_barrier(0);
#pragma unroll
          for (int k = 0; k < 4; ++k) { const int d0 = 4 * dh + k; float t[8]; unpack8(raw[d0], t);
              v4u w; w.x = cvtpk(t[0] * rq * g0[k].x, t[1] * rq * g0[k].y); w.y = cvtpk(t[2] * rq * g0[k].z, t[3] * rq * g0[k].w); w.z = cvtpk(t[4] * rq * g1[k].x, t[5] * rq * g1[k].y); w.w = cvtpk(t[6] * rq * g1[k].z, t[7] * rq * g1[k].w);
              qr[d0] = *reinterpret_cast<bf16x8*>(&w); } }
      f32x4 ga[2][2], gb[2][2];
#pragma unroll
      for (int dd = 0; dd < 2; ++dd) { ga[dd][0] = *(const GAS f32x4*)(qhg + 128 + dd * 16 + hi * 8); ga[dd][1] = *(const GAS f32x4*)(qhg + 128 + dd * 16 + hi * 8 + 4);
          gb[dd][0] = *(const GAS f32x4*)(qhg + 160 + dd * 16 + hi * 8); gb[dd][1] = *(const GAS f32x4*)(qhg + 160 + dd * 16 + hi * 8 + 4); }
      __builtin_amdgcn_sched_barrier(0);
#pragma unroll
      for (int dd = 0; dd < 2; ++dd) {
          float x1[8], x2[8]; unpack8(raw[8 + dd], x1); unpack8(raw[10 + dd], x2);
          const f32x4 a0 = ga[dd][0], a1 = ga[dd][1], b0 = gb[dd][0], b1 = gb[dd][1];
          const float g1v[8] = {a0.x, a0.y, a0.z, a0.w, a1.x, a1.y, a1.z, a1.w}, g2v[8] = {b0.x, b0.y, b0.z, b0.w, b1.x, b1.y, b1.z, b1.w};
          float y1[8], y2[8];
#pragma unroll
          for (int q = 0; q < 4; ++q) { const f32x4 cs = tbv[dd][q];
              const float u0 = x1[2 * q] * rq * g1v[2 * q], v0 = x2[2 * q] * rq * g2v[2 * q], u1 = x1[2 * q + 1] * rq * g1v[2 * q + 1], v1 = x2[2 * q + 1] * rq * g2v[2 * q + 1];
              y1[2 * q] = u0 * cs.x - v0 * cs.y; y2[2 * q] = v0 * cs.x + u0 * cs.y; y1[2 * q + 1] = u1 * cs.z - v1 * cs.w; y2[2 * q + 1] = v1 * cs.z + u1 * cs.w; }
          v4u w1, w2; w1.x = cvtpk(y1[0], y1[1]); w1.y = cvtpk(y1[2], y1[3]); w1.z = cvtpk(y1[4], y1[5]); w1.w = cvtpk(y1[6], y1[7]);
          w2.x = cvtpk(y2[0], y2[1]); w2.y = cvtpk(y2[2], y2[3]); w2.z = cvtpk(y2[4], y2[5]); w2.w = cvtpk(y2[6], y2[7]);
          qr[8 + dd] = *reinterpret_cast<bf16x8*>(&w1); qr[10 + dd] = *reinterpret_cast<bf16x8*>(&w2); }
    }
    const int sr = tid >> 4, sc = (tid & 15) * 8, vst0 = v_st(sr, sc), vst1 = v_st(32 + sr, sc);
    unsigned kgo[3], klo[3];
#pragma unroll
    for (int i = 0; i < 3; ++i) { const int id = tid + 512 * i, kr_ = id / 24, kc_ = id - kr_ * 24; kgo[i] = (unsigned)(kr_ * (QKD * 2) + kc_ * 16); klo[i] = (unsigned)(kr_ * KROW + kc_ * 16); }
    const unsigned vgo0 = (unsigned)(sr * (VD * 2) + sc * 2), vgo1 = vgo0 + 32u * (VD * 2);
    const int vb0 = (int)(uintptr_t)(V_lds) + v_rd_base(lane);
    bf16x8 vs0, vs1, ks0, ks1, ks2;
    const GAS unsigned char* Kg = (const GAS unsigned char*)Kh; const GAS unsigned char* Vg = (const GAS unsigned char*)Vh;
#define SLOAD(k0) do { const GAS unsigned char* kt_ = Kg + (size_t)(k0) * (QKD * 2); const GAS unsigned char* vt_ = Vg + (size_t)(k0) * (VD * 2); \
        vs0 = *(const GAS bf16x8*)(vt_ + vgo0); vs1 = *(const GAS bf16x8*)(vt_ + vgo1); \
        ks0 = *(const GAS bf16x8*)(kt_ + kgo[0]); ks1 = *(const GAS bf16x8*)(kt_ + kgo[1]); ks2 = *(const GAS bf16x8*)(kt_ + kgo[2]); } while (0)
#define SWRITE(b) do { *(LAS bf16x8*)(V_lds + (b) * SHM_V + vst0) = vs0; *(LAS bf16x8*)(V_lds + (b) * SHM_V + vst1) = vs1; \
        *(LAS bf16x8*)(K_lds + (b) * SHM_K + klo[0]) = ks0; *(LAS bf16x8*)(K_lds + (b) * SHM_K + klo[1]) = ks1; *(LAS bf16x8*)(K_lds + (b) * SHM_K + klo[2]) = ks2; } while (0)
    constexpr float ATT_THR = 8.0f;
    SLOAD(0);
    for (int j = 0; j < NT; ++j) {
        const int buf = j & 1;
        if (VAR != 1) { asm volatile("s_waitcnt vmcnt(0)" ::: "memory");
        SWRITE(buf);
        if (j + 1 < NT) SLOAD((j + 1) * 64); }
        if (VAR != 5) WG_BAR();
        if (j <= lw) {
            f32x16 p0, p1;
            { const LAS unsigned char* Kb = K_lds + buf * SHM_K + r32 * KROW + hi * 16;
              { const bf16x8 b0 = *(const LAS bf16x8*)(Kb), b1 = *(const LAS bf16x8*)(Kb + 32 * KROW);
                p0 = __builtin_amdgcn_mfma_f32_32x32x16_bf16(b0, qr[0], negm, 0, 0, 0); p1 = __builtin_amdgcn_mfma_f32_32x32x16_bf16(b1, qr[0], negm, 0, 0, 0); }
#pragma unroll
              for (int d0 = 1; d0 < (VAR == 2 ? 1 : 12); ++d0) { const bf16x8 b0 = *(const LAS bf16x8*)(Kb + d0 * 32), b1 = *(const LAS bf16x8*)(Kb + 32 * KROW + d0 * 32);
                  p0 = __builtin_amdgcn_mfma_f32_32x32x16_bf16(b0, qr[d0], p0, 0, 0, 0); p1 = __builtin_amdgcn_mfma_f32_32x32x16_bf16(b1, qr[d0], p1, 0, 0, 0); } }
            const int vb = vb0 + buf * SHM_V; s16x4 fa[8], fb[8];
            pv_reads<0>(vb, fa);
            if (j == 0) {
#pragma unroll
                for (int r = 8; r < 16; ++r) p0[r] = -1e30f;
#pragma unroll
                for (int r = 0; r < 16; ++r) p1[r] = -1e30f; }
            float pmax = p0[0];
#pragma unroll
            for (int r = 1; r < 16; ++r) pmax = fmaxf(pmax, p0[r]);
#pragma unroll
            for (int r = 0; r < 16; ++r) pmax = fmaxf(pmax, p1[r]);
            { auto rr = __builtin_amdgcn_permlane32_swap(__float_as_uint(pmax), __float_as_uint(pmax), false, false); pmax = fmaxf(__uint_as_float(rr[0]), __uint_as_float(rr[1])); }
            const bool grow = j == 0 || pmax > ATT_THR; float alpha = 1.0f;
            if (__any(grow)) { const float delta = grow ? pmax : 0.f; alpha = __builtin_amdgcn_exp2f(-delta);
#pragma unroll
                for (int r = 0; r < 16; ++r) { p0[r] -= delta; p1[r] -= delta; negm[r] -= delta; }
                if (VAR != 6) { if (hi == 0) al_l[r32] = alpha; asm volatile("s_waitcnt lgkmcnt(0)" ::: "memory");
#pragma unroll
                    for (int r = 0; r < 16; ++r) { const float a = al_l[crow(r, hi)];
#pragma unroll
                        for (int d = 0; d < 4; ++d) o[d][r] *= a; } } }
#pragma unroll
            for (int r = 0; r < 16; ++r) { p0[r] = __builtin_amdgcn_exp2f(p0[r]); p1[r] = __builtin_amdgcn_exp2f(p1[r]); }
            float ps = 0.f;
#pragma unroll
            for (int r = 0; r < 16; ++r) ps += p0[r];
#pragma unroll
            for (int r = 0; r < 16; ++r) ps += p1[r];
            { auto rr = __builtin_amdgcn_permlane32_swap(__float_as_uint(ps), __float_as_uint(ps), false, false); ps = __uint_as_float(rr[0]) + __uint_as_float(rr[1]); }
            l_reg = l_reg * alpha + ps;
            bf16x8 pa0, pa1, pa2, pa3;
#define PK4(P, BASE, OUT) do { unsigned a0 = cvtpk(P[BASE + 0], P[BASE + 1]), a1 = cvtpk(P[BASE + 2], P[BASE + 3]); \
            unsigned b0 = cvtpk(P[BASE + 4], P[BASE + 5]), b1 = cvtpk(P[BASE + 6], P[BASE + 7]); \
            auto r0 = __builtin_amdgcn_permlane32_swap(a0, b0, false, false); auto r1 = __builtin_amdgcn_permlane32_swap(a1, b1, false, false); \
            v4u w = {r0[0], r1[0], r0[1], r1[1]}; OUT = *reinterpret_cast<bf16x8*>(&w); } while (0)
            PK4(p0, 0, pa0); PK4(p0, 8, pa1); PK4(p1, 0, pa2); PK4(p1, 8, pa3);
#undef PK4
            __builtin_amdgcn_sched_barrier(0);
            pv_reads<1>(vb, fb); asm volatile("s_waitcnt lgkmcnt(8)" ::: "memory"); __builtin_amdgcn_sched_barrier(0); pv_mfma(o[0], fa, pa0, pa1, pa2, pa3); __builtin_amdgcn_sched_barrier(0);
            pv_reads<2>(vb, fa); asm volatile("s_waitcnt lgkmcnt(8)" ::: "memory"); __builtin_amdgcn_sched_barrier(0); pv_mfma(o[1], fb, pa0, pa1, pa2, pa3); __builtin_amdgcn_sched_barrier(0);
            pv_reads<3>(vb, fb); asm volatile("s_waitcnt lgkmcnt(8)" ::: "memory"); __builtin_amdgcn_sched_barrier(0); pv_mfma(o[2], fa, pa0, pa1, pa2, pa3); __builtin_amdgcn_sched_barrier(0);
            asm volatile("s_waitcnt lgkmcnt(0)" ::: "memory"); __builtin_amdgcn_sched_barrier(0); pv_mfma(o[3], fb, pa0, pa1, pa2, pa3);
        }
    }
#undef SLOAD
#undef SWRITE
    if (hi == 0) li_l[r32] = l_reg;
    asm volatile("s_waitcnt lgkmcnt(0)" ::: "memory");
    int lane_o = lane; asm volatile("" : "+v"(lane_o));
    const int r32o = lane_o & 31, hio = lane_o >> 5;
    GAS unsigned char* xg = (GAS unsigned char*)XA; const GAS unsigned char* gg = (const GAS unsigned char*)GA;
    unsigned short gv[16][4];
#pragma unroll
    for (int r = 0; r < 16; ++r) { const int i = wid * 32 + crow(r, hio); const unsigned m = (unsigned)(m0 + (i < nrows_out ? i : 0)); const unsigned go = m * (unsigned)(NIN * 2) + (unsigned)r32o * 2u;
#pragma unroll
        for (int d0 = 0; d0 < 4; ++d0) gv[r][d0] = *(const GAS unsigned short*)(gg + go + d0 * 64); }
    __builtin_amdgcn_sched_barrier(0);
#pragma unroll
    for (int r = 0; r < 16; ++r) { const int orow = crow(r, hio), i = wid * 32 + orow; const float rl = __builtin_amdgcn_rcpf(li_l[orow]);
        if (i < nrows_out) { const unsigned m = (unsigned)(m0 + i); const unsigned xo = m * 8192u + (unsigned)r32o * 2u;
#pragma unroll
            for (int d0 = 0; d0 < 4; ++d0) { const float g = __uint_as_float(((unsigned)gv[r][d0]) << 16);
                const float val = o[d0][r] * rl * g; *(GAS unsigned short*)(xg + xo + d0 * 64) = (unsigned short)(cvtpk(val, val) & 0xffffu); } } }
    WG_BAR();
}
template <int VAR>
__device__ __forceinline__ void attn_phase(Frame& F, const float* qhg, bf16* xab_out) {
    const bf16* QRAW = (const bf16*)(F.ws + WS_QRAW); const float* TAB = (const float*)(F.ws + WS_TAB); const bf16* KA = (const bf16*)(F.ws + WS_KA); const bf16* VA = (const bf16*)(F.ws + WS_VA);
    bf16* XAB = xab_out; const bf16* PROJ = (const bf16*)(F.ws + WS_PROJ);
    LAS unsigned char* lds = F.lds + RING_OFF;
    const int wid = F.wave;
    const int npair = (512 - F.vcu + F.G - 1) / F.G, nmeta = F.vcu < 64 ? (64 - F.vcu + F.G - 1) / F.G : 0;
#pragma unroll 1
    for (int u = 0; u < 2 * npair + nmeta; ++u) {
        int bh, pos0, NT, lw, m0, nro;
        if (u < 2 * npair) { const int p = F.vcu + (u >> 1) * F.G, pi = p & 7, qb = (u & 1) ? pi : 15 - pi; bh = p >> 3;
            pos0 = N_META + 256 * qb; NT = 4 * qb + 5; lw = 4 * qb + 1 + (wid >> 1); m0 = (bh >> 4) * SEQ + 256 * qb; nro = 256; }
        else { bh = F.vcu + (u - 2 * npair) * F.G; pos0 = 0; NT = 1; lw = wid == 0 ? 0 : -1; m0 = MMAIN + (bh >> 4) * N_META; nro = 16; }
        const int h = bh & 15;
        attn_unit<VAR>(QRAW + h * QKD, qhg, TAB, pos0, KA + (size_t)bh * LP * QKD, VA + (size_t)bh * LP * VD, NT, lw, XAB + h * 128, PROJ + PC_GA + h * 128, m0, nro, lds);
    }
}
}

template <int NCT, int U, class Fn>
__device__ __forceinline__ void skinny_gemm(LAS unsigned char* lds, const bf16* A, int lda, const bf16* Bt, int ldb, int N, int K, int grp_cols, int a_grp_stride, int cu, int first_cu, int ncus, int G, const Fn& fn) {
    int tid = threadIdx.x; asm volatile("" : "+v"(tid));
    const int wave = __builtin_amdgcn_readfirstlane(tid >> 6), lane = tid & 63, fr = lane & 15, fq = lane >> 4;
    int rel = cu - first_cu; if (rel < 0) rel += G;
    if (rel >= ncus) return;
    const int nitems = N / (16 * NCT), ksl = K >> 3, k0 = wave * ksl;
    constexpr int PW = 64 * 16 * NCT;
#pragma unroll 1
    for (int item = rel; item < nitems; item += ncus) {
        const int n0 = item * 16 * NCT; const int acol = grp_cols ? (n0 / grp_cols) * a_grp_stride : 0;
        pg8::f32x4 acc[4][NCT];
#pragma unroll
        for (int rt = 0; rt < 4; ++rt)
#pragma unroll
            for (int ct = 0; ct < NCT; ++ct) acc[rt][ct] = (pg8::f32x4){0.f, 0.f, 0.f, 0.f};
        const GAS unsigned char* ap = (const GAS unsigned char*)(A + (size_t)fr * lda + acol + k0 + fq * 8);
        const GAS unsigned char* bp = (const GAS unsigned char*)(Bt + (size_t)(n0 + fr) * ldb + k0 + fq * 8);
        const unsigned astep = (unsigned)lda * 32u, bstep = (unsigned)ldb * 32u;
#pragma unroll 1
        for (int ks = 0; ks < ksl; ks += 32 * U) {
            bf16x8 a[U][4], b[U][NCT];
#pragma unroll
            for (int u = 0; u < U; ++u) {
#pragma unroll
                for (int rt = 0; rt < 4; ++rt) a[u][rt] = *(const GAS bf16x8*)(ap + rt * astep + (ks + 32 * u) * 2);
#pragma unroll
                for (int ct = 0; ct < NCT; ++ct) b[u][ct] = *(const GAS bf16x8*)(bp + ct * bstep + (ks + 32 * u) * 2); }
            __builtin_amdgcn_sched_barrier(0);
#pragma unroll
            for (int u = 0; u < U; ++u)
#pragma unroll
                for (int rt = 0; rt < 4; ++rt)
#pragma unroll
                    for (int ct = 0; ct < NCT; ++ct) acc[rt][ct] = __builtin_amdgcn_mfma_f32_16x16x32_bf16(b[u][ct], a[u][rt], acc[rt][ct], 0, 0, 0);
        }
        LAS float* P = (LAS float*)lds + wave * PW;
#pragma unroll
        for (int rt = 0; rt < 4; ++rt)
#pragma unroll
            for (int ct = 0; ct < NCT; ++ct) *(LAS pg8::f32x4*)(P + (rt * 16 + fr) * (16 * NCT) + ct * 16 + 4 * fq) = acc[rt][ct];
        WG_BAR();
        for (int c = tid; c < 64 * 4 * NCT; c += NWAVES * 64) { const int row = c / (4 * NCT), cc = (c - row * (4 * NCT)) * 4; const LAS float* p = (const LAS float*)lds + row * (16 * NCT) + cc;
            pg8::f32x4 vA = *(const LAS pg8::f32x4*)p, vB = *(const LAS pg8::f32x4*)(p + 4 * PW);
#pragma unroll
            for (int w = 1; w < 4; ++w) { vA += *(const LAS pg8::f32x4*)(p + w * PW); vB += *(const LAS pg8::f32x4*)(p + (4 + w) * PW); }
            fn(MMAIN + row, n0 + cc, vA, vB); }
        WG_BAR();
    }
}
__device__ __forceinline__ v2u pack4(const pg8::f32x4& v) { v2u w; w.x = cvtpk(v[0], v[1]); w.y = cvtpk(v[2], v[3]); return w; }
__device__ __forceinline__ float sigm(float x) { return __builtin_amdgcn_rcpf(1.0f + __builtin_amdgcn_exp2f(-1.4426950408889634f * x)); }
struct SkPlain { bf16* O; int ldc; const float* ss; float inv_n;
    __device__ __forceinline__ void operator()(int row, int col, pg8::f32x4 a, pg8::f32x4 b) const { *(GAS v2u*)(O + (size_t)row * ldc + col) = pack4((a + b) * (1.0f / sqrtf(ss[row] * inv_n + NORM_EPS))); } };
struct SkKV { bf16* KRAW; bf16* VA; const float* ss;
    __device__ __forceinline__ void operator()(int row, int col, pg8::f32x4 a, pg8::f32x4 b) const { const int h = col >> 8, c = col & 255; const v2u w = pack4((a + b) * (1.0f / sqrtf(ss[row] * (1.0f / 512.0f) + NORM_EPS)));
        if (c < 128) *(GAS v2u*)(KRAW + (size_t)row * 2048 + h * 128 + c) = w;
        else { const int j = row - MMAIN, bb = j >> 4, pp = j & 15; *(GAS v2u*)(VA + ((size_t)(bb * 16 + h) * LP + pp) * 128 + (c - 128)) = w; } } };
struct SkPool { bf16* XAB; const bf16* PROJ; const float* scale;
    __device__ __forceinline__ void operator()(int row, int col, pg8::f32x4 a, pg8::f32x4 b) const { const pg8::f32x4 sc = *(const GAS pg8::f32x4*)(scale + col); const v2u g = *(const GAS v2u*)(PROJ + (size_t)row * NIN + PC_GB + col);
        pg8::f32x4 v = (a + b) * sc; v[0] *= bflo(g.x); v[1] *= bfhi(g.x); v[2] *= bflo(g.y); v[3] *= bfhi(g.y); *(GAS v2u*)(XAB + (size_t)row * 4096 + 2048 + col) = pack4(v); } };
struct SkBranch { bf16* MG; const bf16* PROJ;
    __device__ __forceinline__ void operator()(int row, int col, pg8::f32x4 a, pg8::f32x4 b) const { const bf16* gp = PROJ + (size_t)row * NIN + PC_MA + (col >> 7) * 256 + (col & 127);
        const v2u gr = *(const GAS v2u*)gp, gb = *(const GAS v2u*)(gp + 128);
        pg8::f32x4 v; v[0] = (a[0] * bflo(gr.x) + b[0]) * bflo(gb.x); v[1] = (a[1] * bfhi(gr.x) + b[1]) * bfhi(gb.x); v[2] = (a[2] * bflo(gr.y) + b[2]) * bflo(gb.y); v[3] = (a[3] * bfhi(gr.y) + b[3]) * bfhi(gb.y);
        *(GAS v2u*)(MG + (size_t)row * 4096 + col) = pack4(v); } };
struct SkRes { bf16* HB; float* PART;
    __device__ __forceinline__ void operator()(int row, int col, pg8::f32x4 a, pg8::f32x4 b) const { const size_t off = (size_t)row * 4096 + col;
        const v2u r = *(const GAS v2u*)(HB + off); pg8::f32x4 h; h[0] = bflo(r.x); h[1] = bfhi(r.x); h[2] = bflo(r.y); h[3] = bfhi(r.y); h = h + a + b;
        *(GAS v2u*)(HB + off) = pack4(h);
        float ssum = (h[0] * h[0] + h[1] * h[1]) + (h[2] * h[2] + h[3] * h[3]); ssum += __shfl_xor(ssum, 1); ssum += __shfl_xor(ssum, 2);
        if ((col & 15) == 0) PART[(size_t)(row - MMAIN) * 256 + (col >> 4)] = ssum; } };
__device__ __forceinline__ void main_ss_reduce(Frame& F, const float* PARTM, float* SSN) {
    int tid = F.tid; asm volatile("" : "+v"(tid));
    for (int row = F.vcu * (NWAVES * 64) + tid; row < MMAIN; row += F.G * NWAVES * 64) { float a0 = 0.f, a1 = 0.f, a2 = 0.f, a3 = 0.f;
#pragma unroll
        for (int k = 0; k < 64; k += 4) { a0 += PARTM[(size_t)k * 16384 + row]; a1 += PARTM[(size_t)(k + 1) * 16384 + row]; a2 += PARTM[(size_t)(k + 2) * 16384 + row]; a3 += PARTM[(size_t)(k + 3) * 16384 + row]; }
        SSN[row] = (a0 + a1) + (a2 + a3); }
}
__device__ __forceinline__ void meta_ss_reduce(Frame& F, const float* PART, float* SSN) {
    const int gw = F.vcu * NWAVES + F.wave; int lane = F.lane; asm volatile("" : "+v"(lane));
    if (gw < NMETA_ROWS) { const pg8::f32x4 v = *((const GAS pg8::f32x4*)(PART + (size_t)gw * 256) + lane); const float t = wave_sum((v[0] + v[1]) + (v[2] + v[3])); if (lane == 0) SSN[MMAIN + gw] = t; }
}

__device__ __forceinline__ int opaque_reps(int n) { if (DBLMASK) asm volatile("" : "+s"(n)); return n; }
struct Args { const float* in[15]; float* out; unsigned char* ws; int ph_lo, ph_hi; };
constexpr int NPHASE = 1 + 7 * DEPTH;

__global__ void __launch_bounds__(NWAVES * 64, 2) trunk_fwd(Args args) {
    extern __shared__ __attribute__((aligned(16))) unsigned char lds_raw[];
    Frame F;
    F.lds = (LAS unsigned char*)lds_raw;
    F.tid = threadIdx.x; F.lane = F.tid & 63; F.wave = __builtin_amdgcn_readfirstlane(F.tid >> 6);
    F.G = gridDim.x; { const int bx = blockIdx.x; F.vcu = (F.G % 8 == 0) ? (bx % 8) * (F.G / 8) + bx / 8 : bx; }
    F.ws = args.ws; F.out = args.out;
#pragma unroll
    for (int i = 0; i < 15; ++i) F.in[i] = args.in[i];
    volatile LAS unsigned* MISC = (volatile LAS unsigned*)(F.lds + MISC_OFF);
    for (int u = F.tid; u < (LDS_BYTES - LDSCTL_OFF) / 4; u += NWAVES * 64) ((LAS unsigned*)(F.lds + LDSCTL_OFF))[u] = 0u;
    __syncthreads();
    unsigned* ctl = (unsigned*)(F.ws + WS_CTL);
    XcdBarrier bar; bar.bar = ctl + CW_BAR; bar.x = 0; bar.st = nullptr;
    if (!MK_PER_PHASE) bar = xcd_barrier_post(ctl + CW_BAR, MISC + 8);
    const int lo = args.ph_lo, hi = args.ph_hi; (void)lo; (void)hi;
#if MK_PER_PHASE
#define IN(k) (lo <= (k) && (k) < hi)
#else
#define IN(k) true
#endif
#ifndef PHMASK
#define PHMASK 0xFFFF
#endif
#define EN(b) ((PHMASK >> (b)) & 1)
#define DBL(b) ((DBLMASK >> (b)) & 1)
#define REPEAT(b) _Pragma("unroll 1") for (int rep_ = 0, nrep_ = opaque_reps(DBL(b) ? 2 : 1); rep_ < nrep_; ++rep_)
#define SEAM(k) do { if (!MK_PER_PHASE && IN((k) + 1)) { const int sk_ = (k); (void)sk_; BARW_BEGIN(); xcd_barrier(bar); BARW_END(); if (DBLMASK & 0x2000) xcd_barrier(bar); } TSTAMP(k); } while (0)
#ifdef TPROBE_SEL
#define TSTAMP(k) do { if (F.tid == 0) { const unsigned now_ = (unsigned)__builtin_amdgcn_s_memrealtime(); const int ty_ = (k) == 0 ? 0 : 1 + ((k) - 1) % 7; MISC[16 + ty_] += now_ - MISC[15]; MISC[15] = now_; } } while (0)
    if (F.tid == 0) MISC[15] = (unsigned)__builtin_amdgcn_s_memrealtime();
#define BARW_BEGIN() const unsigned bw0_ = (unsigned)__builtin_amdgcn_s_memrealtime(); do { int tt_ = F.tid; asm volatile("" : "+v"(tt_)); if (tt_ == 0) { atomicMax(ctl + CW_ARR + 2 * sk_, bw0_); atomicMax(ctl + CW_ARR + 2 * sk_ + 1, ~bw0_); } } while (0)
#ifdef SKEW_TYPE
#define BARW_END() do { } while (0)
#else
#define BARW_END() do { if (F.tid == 0) MISC[16 + 14] += (unsigned)__builtin_amdgcn_s_memrealtime() - bw0_; } while (0)
#endif
#define SKT_BEGIN() unsigned long long skt0_ = __builtin_amdgcn_s_memrealtime()
#define SKT_END() do { if (F.tid == 0) MISC[16 + 8] += (unsigned)(__builtin_amdgcn_s_memrealtime() - skt0_); } while (0)
#else
#define TSTAMP(k) do { } while (0)
#define BARW_BEGIN() do { } while (0)
#define BARW_END() do { } while (0)
#define SKT_BEGIN() do { } while (0)
#define SKT_END() do { } while (0)
#endif

    if (EN(0) && IN(0)) { REPEAT(0) { p0_prologue(F); VM_WAIT(); __syncthreads(); } SEAM(0); }

    for (int l = 0; l < DEPTH; ++l) {
        const int pb = 1 + 7 * l; const bool lastl = (l == DEPTH - 1);
        unsigned char* wl = F.ws + WS_W + (size_t)l * WL_SIZE;
        bf16* PROJ = (bf16*)(F.ws + WS_PROJ);
        const float* SSc = (const float*)(F.ws + WS_SS) + (size_t)(l & 1) * MPA; float* SSn = (float*)(F.ws + WS_SS) + (size_t)((l + 1) & 1) * MPA;
        if (EN(2) && IN(pb + 0)) {
            pg8::Gemm g{(const bf16*)(F.ws + WS_HN), (const bf16*)(wl + WL_IN), 4096, 4096, 4096}; pg8::StaticOrder S; S.init(MPA, NIN, F.G, (int)blockIdx.x);
            pg8::EpiProj E{PROJ, NIN, 14, 30, 30, 62, SSc, 1.0f / 4096.0f, (float*)(F.ws + WS_PARTQ), 6, MPA};
            REPEAT(2) pg8::gemm_phase<pg8::EpiProj, pg8::StaticOrder, PG8_ALIGN, PG8_SP2>(F.lds + RING_OFF, g, S, E);
            SEAM(pb + 0); }
        if (EN(3) && IN(pb + 1)) { REPEAT(3) p3_latent(F, F.in[I_QLG] + (size_t)l * 1024, F.in[I_KVLG] + (size_t)l * 512, lastl ? nullptr : SSn); SEAM(pb + 1); }
        if (IN(pb + 2)) {
            if (EN(4)) {
                pg8::Gemm g{PROJ + PC_CQ, (const bf16*)(wl + WL_UQ), NIN, 1024, 1024}; pg8::StaticOrder S; S.init(MMAIN, 3072, F.G, (int)blockIdx.x);
                pg8::EpiProj E{(bf16*)(F.ws + WS_QRAW), 3072, 0, 0, 0, 0, (const float*)(F.ws + WS_SSQ), 1.0f / 1024.0f, nullptr, 0, 0};
                REPEAT(4) pg8::gemm_phase<pg8::EpiProj, pg8::StaticOrder, PG8_ALIGN, PG8_SP2>(F.lds + RING_OFF, g, S, E);
                { SKT_BEGIN(); REPEAT(12) skinny_gemm<1, 4>(F.lds + RING_OFF, PROJ + (size_t)MMAIN * NIN + PC_CQ, NIN, (const bf16*)(wl + WL_UQ), 1024, 3072, 1024, 0, 0, (int)blockIdx.x, 0, F.G, F.G, SkPlain{(bf16*)(F.ws + WS_QRAW), 3072, (const float*)(F.ws + WS_SSQ), 1.0f / 1024.0f}); SKT_END(); } }
            if (EN(5)) {
                pg8::Gemm g{PROJ + PC_CKV, (const bf16*)(wl + WL_UKV), NIN, 512, 512}; pg8::StaticOrder S; S.init(MMAIN, 4096, F.G, (int)blockIdx.x);
                pg8::EpiKV E{(bf16*)(F.ws + WS_KRAW), (bf16*)(F.ws + WS_VA), LP, (const float*)(F.ws + WS_SSQ) + MPA};
                REPEAT(5) pg8::gemm_phase<pg8::EpiKV, pg8::StaticOrder, PG8_ALIGN, PG8_SP2>(F.lds + RING_OFF, g, S, E);
                { SKT_BEGIN(); REPEAT(12) skinny_gemm<1, 2>(F.lds + RING_OFF, PROJ + (size_t)MMAIN * NIN + PC_CKV, NIN, (const bf16*)(wl + WL_UKV), 512, 4096, 512, 0, 0, (int)blockIdx.x, 0, F.G, F.G, SkKV{(bf16*)(F.ws + WS_KRAW), (bf16*)(F.ws + WS_VA), (const float*)(F.ws + WS_SSQ) + MPA}); SKT_END(); } }
            if (EN(6)) {
                pg8::Gemm g{(const bf16*)(F.ws + WS_DIFF), (const bf16*)(wl + WL_POOL), 2048, 512, 512}; pg8::PoolOrder S; S.init(MMAIN, 2048, F.G, (int)blockIdx.x);
                pg8::EpiPool E{(bf16*)(F.ws + WS_XAB) + 2048, PROJ + PC_GB, NIN, F.in[I_PSCALE] + (size_t)l * 2048};
                REPEAT(6) pg8::gemm_phase<pg8::EpiPool, pg8::PoolOrder, PG8_ALIGN, PG8_SP2>(F.lds + RING_OFF, g, S, E);
                { SKT_BEGIN(); REPEAT(12) skinny_gemm<1, 2>(F.lds + RING_OFF, (const bf16*)(F.ws + WS_DIFF) + (size_t)MMAIN * 2048, 2048, (const bf16*)(wl + WL_POOL), 512, 2048, 512, 512, 512, (int)blockIdx.x, 0, F.G, F.G, SkPool{(bf16*)(F.ws + WS_XAB), PROJ, F.in[I_PSCALE] + (size_t)l * 2048}); SKT_END(); } }
            SEAM(pb + 2); }
        if (EN(7) && IN(pb + 3)) { REPEAT(7) p5_knorm(F, F.in[I_KHG] + (size_t)l * 192); SEAM(pb + 3); }
        if (EN(8) && IN(pb + 4)) { REPEAT(8) att::attn_phase<0>(F, F.in[I_QHG] + (size_t)l * 192, (bf16*)(F.ws + WS_XAB));
#ifdef ATT_PROBE_VAR
            att::attn_phase<ATT_PROBE_VAR>(F, F.in[I_QHG] + (size_t)l * 192, (bf16*)(F.ws + WS_T1));
#endif
            SEAM(pb + 4); }
        if (IN(pb + 5)) {
            if (EN(9)) {
                pg8::Gemm g{(const bf16*)(F.ws + WS_XAB), (const bf16*)(wl + WL_AB), 4096, 4096, 4096}; pg8::StaticOrder S; S.init(MMAIN, 4096, F.G, (int)blockIdx.x);
                pg8::EpiBranch E{(bf16*)(F.ws + WS_MG), PROJ + PC_MA, NIN};
                REPEAT(9) pg8::gemm_phase<pg8::EpiBranch, pg8::StaticOrder, PG8_ALIGN, PG8_SP2>(F.lds + RING_OFF, g, S, E);
                if (!lastl) { SKT_BEGIN(); REPEAT(12) skinny_gemm<1, 8>(F.lds + RING_OFF, (const bf16*)(F.ws + WS_XAB) + (size_t)MMAIN * 4096, 4096, (const bf16*)(wl + WL_AB), 4096, 4096, 4096, 0, 0, (int)blockIdx.x, 0, F.G, F.G, SkBranch{(bf16*)(F.ws + WS_MG), PROJ}); SKT_END(); } }
            SEAM(pb + 5); }
        if (EN(11) && IN(pb + 6)) {
            pg8::Gemm g{(const bf16*)(F.ws + WS_MG), (const bf16*)(wl + WL_OUT), 4096, 4096, 4096}; pg8::StaticOrder S; S.init(MMAIN, 4096, F.G, (int)blockIdx.x);
            pg8::EpiRes E{(bf16*)(F.ws + WS_HN), lastl ? F.out : nullptr, (float*)(F.ws + WS_PARTM)};
            pg8::gemm_phase<pg8::EpiRes, pg8::StaticOrder, PG8_ALIGN, PG8_SP2>(F.lds + RING_OFF, g, S, E);
            if (DBL(11) && lastl) { REPEAT(11) pg8::gemm_phase<pg8::EpiRes, pg8::StaticOrder, PG8_ALIGN, PG8_SP2>(F.lds + RING_OFF, g, S, E); }
            if (!lastl) { SKT_BEGIN(); skinny_gemm<1, 8>(F.lds + RING_OFF, (const bf16*)(F.ws + WS_MG) + (size_t)MMAIN * 4096, 4096, (const bf16*)(wl + WL_OUT), 4096, 4096, 4096, 0, 0, (int)blockIdx.x, 0, F.G, F.G, SkRes{(bf16*)(F.ws + WS_HN), (float*)(F.ws + WS_PART)}); SKT_END(); }
            if (!lastl && !MK_PER_PHASE) { xcd_barrier(bar); main_ss_reduce(F, (const float*)(F.ws + WS_PARTM), SSn); meta_ss_reduce(F, (const float*)(F.ws + WS_PART), SSn); }
            SEAM(pb + 6); }
    }
#ifdef TPROBE_SEL
    TSTAMP(NPHASE - 1);
#ifdef SKEW_TYPE
    if (F.tid == 0) { unsigned acc_ = 0; for (int k = 0; k < NPHASE - 1; ++k) { const int ty_ = k == 0 ? 0 : 1 + (k - 1) % 7; if (ty_ == SKEW_TYPE || SKEW_TYPE == 99) { const unsigned mx_ = xb_ld(ctl + CW_ARR + 2 * k), mn_ = ~xb_ld(ctl + CW_ARR + 2 * k + 1); acc_ += mx_ - mn_; } } MISC[16 + 15] = blockIdx.x == 0 ? acc_ : 0u; }
#endif
    __syncthreads();
    { const unsigned D = MISC[16 + TPROBE_SEL]; const unsigned long long t0 = __builtin_amdgcn_s_memrealtime(); while ((unsigned)(__builtin_amdgcn_s_memrealtime() - t0) < D) __builtin_amdgcn_s_sleep(20); }
#endif
#undef IN
#undef SEAM
}

extern "C" void kernel_launch(void* const* d_in, const int* in_sizes, int n_in, void* d_out, int out_size, void* d_ws, size_t ws_size, hipStream_t stream) {
    static int grid = 0;
    if (grid == 0) {
        if (n_in != 15 || out_size != BATCH * SEQ * D_MODEL || ws_size < WS_END) { fprintf(stderr, "kernel_launch: unexpected shapes (n_in %d out %d ws %zu need %zu)\n", n_in, out_size, ws_size, (size_t)WS_END); grid = -1; return; }
        int dev = 0, cus = 0, per_cu = 0;
        if (hipGetDevice(&dev) != hipSuccess || hipDeviceGetAttribute(&cus, hipDeviceAttributeMultiprocessorCount, dev) != hipSuccess) { grid = -1; return; }
        if (hipFuncSetAttribute((const void*)trunk_fwd, hipFuncAttributeMaxDynamicSharedMemorySize, LDS_BYTES) != hipSuccess) { fprintf(stderr, "kernel_launch: hipFuncSetAttribute failed\n"); grid = -1; return; }
        if (hipOccupancyMaxActiveBlocksPerMultiprocessor(&per_cu, (const void*)trunk_fwd, NWAVES * 64, LDS_BYTES) != hipSuccess || per_cu < 1) fprintf(stderr, "kernel_launch: occupancy query says %d\n", per_cu);
        (void)hipGetLastError();
        grid = cus;
    }
    if (grid < 0) return;
    if (hipMemsetAsync((char*)d_ws + WS_CTL, 0, (CW_ARR + 256) * 4, stream) != hipSuccess) return;
    Args a{};
    for (int i = 0; i < 15; ++i) a.in[i] = (const float*)d_in[i];
    a.out = (float*)d_out; a.ws = (unsigned char*)d_ws;
#if MK_PER_PHASE
    for (int p = 0; p < NPHASE; ++p) { a.ph_lo = p; a.ph_hi = p + 1; hipLaunchKernelGGL(trunk_fwd, dim3(grid), dim3(NWAVES * 64), LDS_BYTES, stream, a); }
#else
    a.ph_lo = 0; a.ph_hi = NPHASE; hipLaunchKernelGGL(trunk_fwd, dim3(grid), dim3(NWAVES * 64), LDS_BYTES, stream, a);
#endif
    (void)in_sizes;
}
```

```cpp
#include <hip/hip_runtime.h>
#include <cstdio>
#include <cstdint>

#ifndef MK_PER_PHASE
#define MK_PER_PHASE 0
#endif

namespace pg8 {
#define PG8_LAS __attribute__((address_space(3)))
typedef unsigned short bf16_t;
typedef short bf16x8 __attribute__((ext_vector_type(8)));
typedef float f32x4 __attribute__((ext_vector_type(4)));
typedef unsigned u32x4 __attribute__((ext_vector_type(4)));
constexpr int BM = 256, BK = 64, HALF = 128, HTB = HALF * BK * 2  , STAGE_BYTES = 8 * HTB, NXCD = 8, WGM = 4;

__host__ __device__ __forceinline__ int lds_byte(int r, int c) { const int st = (r >> 4) * 2 + (c >> 5), rr = r & 15, cc = c & 31, ob = rr * 64 + cc * 2; return st * 1024 + (ob ^ (((ob >> 9) & 1) << 5)); }
__host__ __device__ __forceinline__ void stage_rc(int b, int& R, int& C) { const int st = b / 1024, sb = b % 1024, swz = sb ^ (((sb >> 9) & 1) << 5); R = (st >> 1) * 16 + swz / 64; C = (st & 1) * 32 + (swz % 64) / 2; }
__host__ __device__ __forceinline__ int perm32(int rho) { const int n = rho >> 4, i = rho & 15; return 8 * (i >> 2) + 4 * n + (i & 3); }

struct Unit { int pm, pn; unsigned aoff; };
struct Gemm { const bf16_t* A; const bf16_t* Bt; int lda, ldb, K; };

struct StaticOrder {
    int nM, nN, nwg, G, c;
    __host__ __device__ void init(int M, int N, int G_, int c_) { nM = M / BM; nN = N / BM; nwg = nM * nN; G = G_; c = c_; }
    __host__ __device__ bool next(int i, Unit& u) const {
        const long L = (long)i * G + c; if (L >= nwg) return false;
        int wgid = (int)L; { const int q = nwg / NXCD, r = nwg % NXCD, xcd = wgid % NXCD, off = wgid / NXCD; wgid = (xcd < r ? xcd * (q + 1) : r * (q + 1) + (xcd - r) * q) + off; }
        const int nig = WGM * nN, gid = wgid / nig, fm = gid * WGM, gsz = (nM - fm) < WGM ? (nM - fm) : WGM;
        u.pm = fm + ((wgid % nig) % gsz); u.pn = (wgid % nig) / gsz; u.aoff = 0u; return true;
    }
    __device__ __forceinline__ void a_ready(const Unit&) const {}
    __device__ __forceinline__ void done(const Unit&) const {}
};
__device__ __forceinline__ unsigned cvt_pk_bf16(float lo, float hi) { unsigned r; asm volatile("v_cvt_pk_bf16_f32 %0, %1, %2" : "=v"(r) : "v"(lo), "v"(hi)); return r; }
typedef unsigned u32x2 __attribute__((ext_vector_type(2)));
__device__ __forceinline__ float bflo(unsigned u) { return __uint_as_float(u << 16); }
__device__ __forceinline__ float bfhi(unsigned u) { return __uint_as_float(u & 0xffff0000u); }
__device__ __forceinline__ float sigmoidf_(float x) { return __builtin_amdgcn_rcpf(1.0f + __builtin_amdgcn_exp2f(-1.4426950408889634f * x)); }


#ifndef NT_STORE
#define NT_STORE 0
#endif
struct EpiProj {
    static constexpr bool PERM = true, AFTER_DRAIN = false, MID = false; static constexpr int TAG = 9;
    bf16_t* O; int ldc; int silu_lo, silu_hi, sig_lo, sig_hi; const float* ss; float inv_n; float* partq; int pq_tiles, pq_stride;
    __device__ __forceinline__ void operator()(const f32x4 (&acc)[2][2][4][2], const Unit& u, int wr, int wc, int fr, int fq) const {
        const int row0 = u.pm * BM + wr * 64 + fr; const int col0 = u.pn * BM + wc * 32 + 8 * fq;
        const int act = (u.pn >= silu_lo && u.pn < silu_hi) ? 1 : ((u.pn >= sig_lo && u.pn < sig_hi) ? 2 : 0);
        float rs[2][4];
#pragma unroll
        for (int ai = 0; ai < 2; ++ai)
#pragma unroll
            for (int m = 0; m < 4; ++m) rs[ai][m] = ss ? ss[row0 + ai * HALF + m * 16] : 0.f;
        __builtin_amdgcn_sched_barrier(0);
#pragma unroll
        for (int ai = 0; ai < 2; ++ai)
#pragma unroll
            for (int m = 0; m < 4; ++m) { const int row = row0 + ai * HALF + m * 16; bf16_t* rowp = O + (size_t)row * ldc + col0;
                const float r = ss ? 1.0f / sqrtf(rs[ai][m] * inv_n + 1e-6f) : 1.0f;
                if (act == 2) {
                    f32x4 a0 = acc[ai][0][m][0] * r, a1 = acc[ai][0][m][1] * r, b0 = acc[ai][1][m][0] * r, b1 = acc[ai][1][m][1] * r;
#pragma unroll
                    for (int j = 0; j < 4; ++j) { const float sb0 = fmaxf(sigmoidf_(b0[j]), 1e-6f), sb1 = fmaxf(sigmoidf_(b1[j]), 1e-6f);
                        a0[j] = sigmoidf_(a0[j]) * __builtin_amdgcn_rcpf(sb0); a1[j] = sigmoidf_(a1[j]) * __builtin_amdgcn_rcpf(sb1); b0[j] = sb0; b1[j] = sb1; }
                    u32x4 w; w.x = cvt_pk_bf16(a0[0], a0[1]); w.y = cvt_pk_bf16(a0[2], a0[3]); w.z = cvt_pk_bf16(a1[0], a1[1]); w.w = cvt_pk_bf16(a1[2], a1[3]); *(u32x4*)rowp = w;
                    w.x = cvt_pk_bf16(b0[0], b0[1]); w.y = cvt_pk_bf16(b0[2], b0[3]); w.z = cvt_pk_bf16(b1[0], b1[1]); w.w = cvt_pk_bf16(b1[2], b1[3]); *(u32x4*)(rowp + HALF) = w;
                } else {
                float psq = 0.f;
#pragma unroll
                for (int bj = 0; bj < 2; ++bj) { f32x4 v0 = acc[ai][bj][m][0] * r, v1 = acc[ai][bj][m][1] * r;
                    psq += ((v0[0] * v0[0] + v0[1] * v0[1]) + (v0[2] * v0[2] + v0[3] * v0[3])) + ((v1[0] * v1[0] + v1[1] * v1[1]) + (v1[2] * v1[2] + v1[3] * v1[3]));
                    if (act) {
#pragma unroll
                        for (int j = 0; j < 4; ++j) { const float s0 = sigmoidf_(v0[j]), s1 = sigmoidf_(v1[j]); v0[j] = v0[j] * s0; v1[j] = v1[j] * s1; } }
                    u32x4 w; w.x = cvt_pk_bf16(v0[0], v0[1]); w.y = cvt_pk_bf16(v0[2], v0[3]); w.z = cvt_pk_bf16(v1[0], v1[1]); w.w = cvt_pk_bf16(v1[2], v1[3]);
                    if (NT_STORE) __builtin_nontemporal_store(w, (u32x4*)(rowp + bj * HALF)); else *(u32x4*)(rowp + bj * HALF) = w; }
                if (partq && u.pn < pq_tiles) { psq += __shfl_xor(psq, 16); psq += __shfl_xor(psq, 32); if (fq == 0) partq[(size_t)(u.pn * 4 + wc) * pq_stride + row] = psq; } } }
    }
};
struct EpiKV {
    static constexpr bool PERM = true, AFTER_DRAIN = false, MID = false; static constexpr int TAG = 10;
    bf16_t* KRAW; bf16_t* VA; int lp; const float* ss;
    __device__ __forceinline__ void operator()(const f32x4 (&acc)[2][2][4][2], const Unit& u, int wr, int wc, int fr, int fq) const {
        const int row0 = u.pm * BM + wr * 64 + fr; const int h = u.pn; const int c0 = wc * 32 + 8 * fq;
        float rs[2][4];
#pragma unroll
        for (int ai = 0; ai < 2; ++ai)
#pragma unroll
            for (int m = 0; m < 4; ++m) rs[ai][m] = ss[row0 + ai * HALF + m * 16];
        __builtin_amdgcn_sched_barrier(0);
#pragma unroll
        for (int ai = 0; ai < 2; ++ai)
#pragma unroll
            for (int m = 0; m < 4; ++m) { const int row = row0 + ai * HALF + m * 16; const float r = 1.0f / sqrtf(rs[ai][m] * (1.0f / 512.0f) + 1e-6f);
                { const f32x4 v0 = acc[ai][0][m][0] * r, v1 = acc[ai][0][m][1] * r; u32x4 w; w.x = cvt_pk_bf16(v0[0], v0[1]); w.y = cvt_pk_bf16(v0[2], v0[3]); w.z = cvt_pk_bf16(v1[0], v1[1]); w.w = cvt_pk_bf16(v1[2], v1[3]);
                  *(u32x4*)(KRAW + (size_t)row * 2048 + h * 128 + c0) = w; }
                { const int b = row >> 12, pp = 64 + (row & 4095);
                  const f32x4 v0 = acc[ai][1][m][0] * r, v1 = acc[ai][1][m][1] * r; u32x4 w; w.x = cvt_pk_bf16(v0[0], v0[1]); w.y = cvt_pk_bf16(v0[2], v0[3]); w.z = cvt_pk_bf16(v1[0], v1[1]); w.w = cvt_pk_bf16(v1[2], v1[3]);
                  *(u32x4*)(VA + ((size_t)(b * 16 + h) * lp + pp) * 128 + c0) = w; } }
    }
};
struct EpiPool {
    static constexpr bool PERM = true, AFTER_DRAIN = false, MID = false; static constexpr int TAG = 11;
    bf16_t* XAB; const bf16_t* GB; int ldg; const float* scale;
    __device__ __forceinline__ void operator()(const f32x4 (&acc)[2][2][4][2], const Unit& u, int wr, int wc, int fr, int fq) const {
        const int row0 = u.pm * BM + wr * 64 + fr; const int col0 = u.pn * BM + wc * 32 + 8 * fq;
        f32x4 sc[2][2]; u32x4 g[2][4][2];
#pragma unroll
        for (int bj = 0; bj < 2; ++bj)
#pragma unroll
            for (int n = 0; n < 2; ++n) sc[bj][n] = *(const f32x4*)(scale + col0 + bj * HALF + 4 * n);
#pragma unroll
        for (int ai = 0; ai < 2; ++ai)
#pragma unroll
            for (int m = 0; m < 4; ++m)
#pragma unroll
                for (int bj = 0; bj < 2; ++bj) g[ai][m][bj] = *(const u32x4*)((const char*)GB + ((unsigned)(row0 + ai * HALF + m * 16) * (unsigned)ldg + (unsigned)(col0 + bj * HALF)) * 2u);
        __builtin_amdgcn_sched_barrier(0);
#pragma unroll
        for (int ai = 0; ai < 2; ++ai)
#pragma unroll
            for (int m = 0; m < 4; ++m) { const size_t row = (size_t)(row0 + ai * HALF + m * 16);
#pragma unroll
                for (int bj = 0; bj < 2; ++bj) { const u32x4 gg = g[ai][m][bj];
                    const f32x4 v0 = acc[ai][bj][m][0] * sc[bj][0], v1 = acc[ai][bj][m][1] * sc[bj][1];
                    u32x4 w; w.x = cvt_pk_bf16(v0[0] * bflo(gg.x), v0[1] * bfhi(gg.x)); w.y = cvt_pk_bf16(v0[2] * bflo(gg.y), v0[3] * bfhi(gg.y));
                    w.z = cvt_pk_bf16(v1[0] * bflo(gg.z), v1[1] * bfhi(gg.z)); w.w = cvt_pk_bf16(v1[2] * bflo(gg.w), v1[3] * bfhi(gg.w));
                    *(u32x4*)(XAB + row * 4096 + col0 + bj * HALF) = w; } }
    }
};
__device__ __forceinline__ float gate_b(float s) { return fmaxf(s, 1e-6f); }
struct EpiBranch {
    static constexpr bool PERM = true, AFTER_DRAIN = false, MID = true; static constexpr int TAG = 12;
    bf16_t* MG; const bf16_t* RS; int ldg;
    __device__ __forceinline__ void mid(f32x4 (&acc)[2][2][4][2], const Unit& u, int wr, int wc, int fr, int fq) const {
        asm volatile("" : "+v"(fr), "+v"(fq));
        const int row0 = u.pm * BM + wr * 64 + fr; const int gc0 = u.pn * 512 + wc * 32 + 8 * fq;
        u32x4 a[2][4][2];
#pragma unroll
        for (int ai = 0; ai < 2; ++ai)
#pragma unroll
            for (int m = 0; m < 4; ++m)
#pragma unroll
                for (int bj = 0; bj < 2; ++bj) a[ai][m][bj] = *(const u32x4*)((const char*)RS + ((unsigned)(row0 + ai * HALF + m * 16) * (unsigned)ldg + (unsigned)(gc0 + 256 * bj)) * 2u);
        __builtin_amdgcn_sched_barrier(0);
#pragma unroll
        for (int ai = 0; ai < 2; ++ai)
#pragma unroll
            for (int m = 0; m < 4; ++m)
#pragma unroll
                for (int bj = 0; bj < 2; ++bj) { const u32x4 aa = a[ai][m][bj]; f32x4 r0, r1;
                    r0[0] = bflo(aa.x); r0[1] = bfhi(aa.x); r0[2] = bflo(aa.y); r0[3] = bfhi(aa.y); r1[0] = bflo(aa.z); r1[1] = bfhi(aa.z); r1[2] = bflo(aa.w); r1[3] = bfhi(aa.w);
                    acc[ai][bj][m][0] *= r0; acc[ai][bj][m][1] *= r1; }
        __builtin_amdgcn_sched_barrier(0);
    }
    __device__ __forceinline__ void operator()(const f32x4 (&acc)[2][2][4][2], const Unit& u, int wr, int wc, int fr, int fq) const {
        const int row0 = u.pm * BM + wr * 64 + fr; const int col0 = u.pn * BM + wc * 32 + 8 * fq, gc0 = u.pn * 512 + wc * 32 + 8 * fq + 128;
        u32x4 g[2][4][2];
#pragma unroll
        for (int ai = 0; ai < 2; ++ai)
#pragma unroll
            for (int m = 0; m < 4; ++m)
#pragma unroll
                for (int bj = 0; bj < 2; ++bj) g[ai][m][bj] = *(const u32x4*)((const char*)RS + ((unsigned)(row0 + ai * HALF + m * 16) * (unsigned)ldg + (unsigned)(gc0 + 256 * bj)) * 2u);
        __builtin_amdgcn_sched_barrier(0);
#pragma unroll
        for (int ai = 0; ai < 2; ++ai)
#pragma unroll
            for (int m = 0; m < 4; ++m) { const size_t row = (size_t)(row0 + ai * HALF + m * 16);
#pragma unroll
                for (int bj = 0; bj < 2; ++bj) { const u32x4 b = g[ai][m][bj]; const f32x4 v0 = acc[ai][bj][m][0], v1 = acc[ai][bj][m][1];
                    u32x4 w; w.x = cvt_pk_bf16(v0[0] * bflo(b.x), v0[1] * bfhi(b.x)); w.y = cvt_pk_bf16(v0[2] * bflo(b.y), v0[3] * bfhi(b.y));
                    w.z = cvt_pk_bf16(v1[0] * bflo(b.z), v1[1] * bfhi(b.z)); w.w = cvt_pk_bf16(v1[2] * bflo(b.w), v1[3] * bfhi(b.w));
                    *(u32x4*)(MG + row * 4096 + col0 + bj * HALF) = w; } }
    }
};
struct EpiRes {
    static constexpr bool PERM = true, AFTER_DRAIN = false, MID = false; static constexpr int TAG = 13;
    bf16_t* HB; float* OUT; float* PARTM;
    __device__ __forceinline__ void operator()(const f32x4 (&acc)[2][2][4][2], const Unit& u, int wr, int wc, int fr, int fq) const {
        const int row0 = u.pm * BM + wr * 64 + fr, col0 = u.pn * BM + wc * 32 + 8 * fq;
#pragma unroll
        for (int ai = 0; ai < 2; ++ai) {
            u32x4 hv[4][2];
#pragma unroll
            for (int m = 0; m < 4; ++m)
#pragma unroll
                for (int bj = 0; bj < 2; ++bj) hv[m][bj] = *(const u32x4*)(HB + (size_t)(row0 + ai * HALF + m * 16) * 4096 + col0 + bj * HALF);
            __builtin_amdgcn_sched_barrier(0);
            if (OUT) {
#pragma unroll
                for (int m = 0; m < 4; ++m)
#pragma unroll
                    for (int bj = 0; bj < 2; ++bj) { const u32x4 r = hv[m][bj]; float* o = OUT + (size_t)(row0 + ai * HALF + m * 16) * 4096 + col0 + bj * HALF;
                        f32x4 h0, h1; h0[0] = bflo(r.x); h0[1] = bfhi(r.x); h0[2] = bflo(r.y); h0[3] = bfhi(r.y); h1[0] = bflo(r.z); h1[1] = bfhi(r.z); h1[2] = bflo(r.w); h1[3] = bfhi(r.w);
                        *(f32x4*)o = h0 + acc[ai][bj][m][0]; *(f32x4*)(o + 4) = h1 + acc[ai][bj][m][1]; }
            } else {
#pragma unroll
                for (int m = 0; m < 4; ++m) { const int row = row0 + ai * HALF + m * 16; float ssum = 0.f;
#pragma unroll
                    for (int bj = 0; bj < 2; ++bj) { const u32x4 r = hv[m][bj];
                        f32x4 h0, h1; h0[0] = bflo(r.x); h0[1] = bfhi(r.x); h0[2] = bflo(r.y); h0[3] = bfhi(r.y); h1[0] = bflo(r.z); h1[1] = bfhi(r.z); h1[2] = bflo(r.w); h1[3] = bfhi(r.w);
                        h0 += acc[ai][bj][m][0]; h1 += acc[ai][bj][m][1];
                        ssum += ((h0[0] * h0[0] + h0[1] * h0[1]) + (h0[2] * h0[2] + h0[3] * h0[3])) + ((h1[0] * h1[0] + h1[1] * h1[1]) + (h1[2] * h1[2] + h1[3] * h1[3]));
                        u32x4 w; w.x = cvt_pk_bf16(h0[0], h0[1]); w.y = cvt_pk_bf16(h0[2], h0[3]); w.z = cvt_pk_bf16(h1[0], h1[1]); w.w = cvt_pk_bf16(h1[2], h1[3]);
                        *(u32x4*)(HB + (size_t)row * 4096 + col0 + bj * HALF) = w; }
                    ssum += __shfl_xor(ssum, 16); ssum += __shfl_xor(ssum, 32);
                    if (fq == 0) PARTM[(size_t)(u.pn * 4 + wc) * 16384 + row] = ssum; }
            }
            __builtin_amdgcn_sched_barrier(0);
        }
    }
};
struct PoolOrder : StaticOrder {
    __host__ __device__ bool next(int i, Unit& u) const { if (!StaticOrder::next(i, u)) return false; u.aoff = (unsigned)(u.pn >> 1) * 1024u; return true; }
};

template <class Epi, class Sched, bool ALIGN_EPI = false, bool SP2 = false>
__device__ __forceinline__ void gemm_phase(PG8_LAS unsigned char* lds, const Gemm g, const Sched& S, const Epi& E) {
    int tid = threadIdx.x; asm volatile("" : "+v"(tid));
    const int wid = __builtin_amdgcn_readfirstlane(tid >> 6), lane = tid & 63, wr = wid >> 2, wc = wid & 3, fr = lane & 15, fq = lane >> 4;
    const int K = g.K, nt = K / BK;
    unsigned voffA[2], voffB[2];
#pragma unroll
    for (int i = 0; i < 2; ++i) { int R, C; stage_rc(tid * 16 + i * 8192, R, C); const int Rb = Epi::PERM ? ((R & ~31) + perm32(R & 31)) : R;
        voffA[i] = (unsigned)(R * g.lda + C) * 2u; voffB[i] = (unsigned)(Rb * g.ldb + C) * 2u; }
    const size_t kstep = (size_t)(BK * 2);
    const size_t hstepA = (size_t)HALF * g.lda * 2, hstepB = (size_t)HALF * g.ldb * 2;
    const size_t tstepA = 2 * hstepA, tstepB = 2 * hstepB;
    const unsigned ldsw = (unsigned)wid * 1024u;
    const int aoff = lds_byte(wr * 64 + fr, fq * 8), boff = lds_byte(wc * 32 + fr, fq * 8);
#define PG8_SA(b, h) (((b) * 2 + (h)) * HTB)
#define PG8_SB(b, h) ((4 + (b) * 2 + (h)) * HTB)
#define PG8_STAGE(bufoff, gbase, voff) do { _Pragma("unroll") for (int _i = 0; _i < 2; ++_i) \
        __builtin_amdgcn_global_load_lds((const unsigned*)((const char*)(gbase) + (voff)[_i]), (PG8_LAS unsigned*)(lds + (bufoff) + ldsw + _i * 8192), 16, 0, 0); } while (0)
#define PG8_LDA(dst, b, h) do { _Pragma("unroll") for (int m = 0; m < 4; ++m) _Pragma("unroll") for (int k = 0; k < 2; ++k) dst[m][k] = *(const PG8_LAS bf16x8*)(lds + PG8_SA(b, h) + aoff + m * 2048 + k * 1024); } while (0)
#define PG8_LDB(dst, b, h) do { _Pragma("unroll") for (int n = 0; n < 2; ++n) _Pragma("unroll") for (int k = 0; k < 2; ++k) dst[n][k] = *(const PG8_LAS bf16x8*)(lds + PG8_SB(b, h) + boff + n * 2048 + k * 1024); } while (0)
#define PG8_MMA(ai, bj, At, Bt) do { __builtin_amdgcn_s_setprio(1); _Pragma("unroll") for (int m = 0; m < 4; ++m) _Pragma("unroll") for (int n = 0; n < 2; ++n) _Pragma("unroll") for (int k = 0; k < 2; ++k) \
        acc[ai][bj][m][n] = __builtin_amdgcn_mfma_f32_16x16x32_bf16(Bt[n][k], At[m][k], acc[ai][bj][m][n], 0, 0, 0); __builtin_amdgcn_s_setprio(0); } while (0)
#define PG8_WAIT_V(n) asm volatile("s_waitcnt vmcnt(" #n ")" ::: "memory")
#define PG8_WAIT_L(n) asm volatile("s_waitcnt lgkmcnt(" #n ")" ::: "memory")
#define PG8_BAR __builtin_amdgcn_s_barrier()
#define PG8_SCHED __builtin_amdgcn_sched_barrier(0)
    Unit cur, nxt; int ui = 0;
    if (!S.next(0, cur)) return;
    f32x4 acc[2][2][4][2];
#pragma unroll
    for (int a = 0; a < 2; ++a)
#pragma unroll
        for (int b = 0; b < 2; ++b)
#pragma unroll
            for (int m = 0; m < 4; ++m)
#pragma unroll
                for (int n = 0; n < 2; ++n) acc[a][b][m][n] = (f32x4){0.f, 0.f, 0.f, 0.f};
    bf16x8 At[4][2], B0[2][2], B1[2][2];
    const char* cA = (const char*)g.A + (size_t)cur.pm * tstepA + cur.aoff; const char* cB = (const char*)g.Bt + (size_t)cur.pn * tstepB;
    S.a_ready(cur);
    if constexpr (SP2) {
        PG8_STAGE(PG8_SB(0, 0), cB, voffB); PG8_STAGE(PG8_SB(0, 1), cB + hstepB, voffB); PG8_STAGE(PG8_SA(0, 0), cA, voffA); PG8_STAGE(PG8_SA(0, 1), cA + hstepA, voffA);
        if (wr == 1) PG8_BAR;
        PG8_WAIT_V(2); PG8_BAR;
        PG8_STAGE(PG8_SB(1, 0), cB + kstep, voffB); PG8_STAGE(PG8_SA(1, 0), cA + kstep, voffA); PG8_STAGE(PG8_SB(1, 1), cB + hstepB + kstep, voffB);
        PG8_WAIT_V(6); PG8_BAR;
    } else {
        PG8_STAGE(PG8_SB(0, 0), cB, voffB); PG8_STAGE(PG8_SA(0, 0), cA, voffA); PG8_STAGE(PG8_SB(0, 1), cB + hstepB, voffB); PG8_STAGE(PG8_SA(0, 1), cA + hstepA, voffA);
        if (wr == 1) PG8_BAR;
        PG8_WAIT_V(4); PG8_BAR;
        PG8_STAGE(PG8_SB(1, 0), cB + kstep, voffB); PG8_STAGE(PG8_SA(1, 0), cA + kstep, voffA); PG8_STAGE(PG8_SB(1, 1), cB + hstepB + kstep, voffB);
        PG8_WAIT_V(6); PG8_BAR;
    }
    for (;;) {
        const bool has_next = S.next(ui + 1, nxt);
        const char* nA = has_next ? (const char*)g.A + (size_t)nxt.pm * tstepA + nxt.aoff : cA; const char* nB = has_next ? (const char*)g.Bt + (size_t)nxt.pn * tstepB : cB;
        for (int t = 0; t < nt; t += 2) {
            const bool last = (t == nt - 2);
            if constexpr (Epi::MID) { if (t == (nt >> 1)) E.mid(acc, cur, wr, wc, fr, fq); }
            const char* a1 = cA + (size_t)(t + 1) * kstep;
            const char* a2 = last ? nA : cA + (size_t)(t + 2) * kstep; const char* b2 = last ? nB : cB + (size_t)(t + 2) * kstep;
            const char* a3 = a2 + kstep; const char* b3 = b2 + kstep;
            if (last && has_next) S.a_ready(nxt);
            if constexpr (SP2) {
            PG8_LDB(B0, 0, 0); PG8_LDB(B1, 0, 1); PG8_SCHED; PG8_LDA(At, 0, 0); PG8_STAGE(PG8_SA(1, 1), a1 + hstepA, voffA);
            PG8_WAIT_V(8); PG8_WAIT_L(0); PG8_BAR; PG8_MMA(0, 0, At, B0); PG8_MMA(0, 1, At, B1); PG8_BAR; PG8_SCHED;
            PG8_LDA(At, 0, 1); PG8_STAGE(PG8_SB(0, 0), b2, voffB); PG8_STAGE(PG8_SB(0, 1), b2 + hstepB, voffB); PG8_STAGE(PG8_SA(0, 0), a2, voffA);
            PG8_WAIT_V(8); PG8_WAIT_L(0); PG8_BAR; PG8_MMA(1, 0, At, B0); PG8_MMA(1, 1, At, B1); PG8_BAR; PG8_SCHED;
            PG8_LDB(B0, 1, 0); PG8_LDB(B1, 1, 1); PG8_SCHED; PG8_LDA(At, 1, 0); PG8_STAGE(PG8_SA(0, 1), a2 + hstepA, voffA);
            PG8_WAIT_V(8); PG8_WAIT_L(0); PG8_BAR; PG8_MMA(0, 0, At, B0); PG8_MMA(0, 1, At, B1); PG8_BAR; PG8_SCHED;
            PG8_LDA(At, 1, 1); PG8_STAGE(PG8_SB(1, 0), b3, voffB); PG8_STAGE(PG8_SB(1, 1), b3 + hstepB, voffB); PG8_STAGE(PG8_SA(1, 0), a3, voffA);
            PG8_WAIT_V(8); PG8_WAIT_L(0); PG8_BAR; PG8_MMA(1, 0, At, B0); PG8_MMA(1, 1, At, B1); PG8_BAR; PG8_SCHED;
            } else {
            PG8_LDB(B0, 0, 0); PG8_SCHED; PG8_LDA(At, 0, 0); PG8_STAGE(PG8_SA(1, 1), a1 + hstepA, voffA);
            PG8_WAIT_L(8); PG8_BAR; PG8_WAIT_L(0); PG8_MMA(0, 0, At, B0); PG8_BAR; PG8_SCHED;
            PG8_LDB(B1, 0, 1); PG8_STAGE(PG8_SB(0, 0), b2, voffB);
            PG8_BAR; PG8_WAIT_L(0); PG8_MMA(0, 1, At, B1); PG8_BAR;
            PG8_LDA(At, 0, 1); PG8_STAGE(PG8_SA(0, 0), a2, voffA);
            PG8_BAR; PG8_WAIT_L(0); PG8_MMA(1, 0, At, B0); PG8_BAR; PG8_SCHED;
            PG8_STAGE(PG8_SB(0, 1), b2 + hstepB, voffB);
            PG8_WAIT_V(6); PG8_BAR; PG8_MMA(1, 1, At, B1); PG8_BAR;
            PG8_LDB(B0, 1, 0); PG8_SCHED; PG8_LDA(At, 1, 0); PG8_STAGE(PG8_SA(0, 1), a2 + hstepA, voffA);
            PG8_WAIT_L(8); PG8_BAR; PG8_WAIT_L(0); PG8_MMA(0, 0, At, B0); PG8_BAR; PG8_SCHED;
            PG8_LDB(B1, 1, 1); PG8_STAGE(PG8_SB(1, 0), b3, voffB);
            PG8_BAR; PG8_WAIT_L(0); PG8_MMA(0, 1, At, B1); PG8_BAR;
            PG8_LDA(At, 1, 1); PG8_STAGE(PG8_SA(1, 0), a3, voffA);
            PG8_BAR; PG8_WAIT_L(0); PG8_MMA(1, 0, At, B0); PG8_BAR; PG8_SCHED;
            PG8_STAGE(PG8_SB(1, 1), b3 + hstepB, voffB);
            PG8_WAIT_V(6); PG8_BAR; PG8_MMA(1, 1, At, B1); PG8_BAR;
            }
        }
        if constexpr (ALIGN_EPI) { if (wr == 0) PG8_BAR; }
#ifdef TPROBE_SEL
        unsigned te0_ = 0; if constexpr (Epi::TAG == TPROBE_SEL) te0_ = (unsigned)__builtin_amdgcn_s_memrealtime();
#endif
        if constexpr (!Epi::AFTER_DRAIN) { E(acc, cur, wr, wc, fr, fq); S.done(cur); }
#ifdef TPROBE_SEL
        if constexpr (Epi::TAG == TPROBE_SEL) if (tid == 0) { asm volatile("s_waitcnt vmcnt(0)" ::: "memory"); ((volatile PG8_LAS unsigned*)(lds + 131072 + 320))[16 + Epi::TAG] += (unsigned)__builtin_amdgcn_s_memrealtime() - te0_; }
#endif
        if (!has_next) break;
#pragma unroll
        for (int a = 0; a < 2; ++a)
#pragma unroll
            for (int b = 0; b < 2; ++b)
#pragma unroll
                for (int m = 0; m < 4; ++m)
#pragma unroll
                    for (int n = 0; n < 2; ++n) acc[a][b][m][n] = (f32x4){0.f, 0.f, 0.f, 0.f};
        cur = nxt; cA = nA; cB = nB; ++ui;
        if constexpr (ALIGN_EPI) { if (wr == 1) PG8_BAR; }
    }
    PG8_WAIT_V(0);
    if constexpr (!ALIGN_EPI) { if (wr == 0) PG8_BAR; }
    PG8_BAR;
    if constexpr (Epi::AFTER_DRAIN) { E.fused(acc, cur, wr, wc, fr, fq, lds, wid, lane); S.done(cur); }
#undef PG8_SA
#undef PG8_SB
#undef PG8_STAGE
#undef PG8_LDA
#undef PG8_LDB
#undef PG8_MMA
#undef PG8_WAIT_V
#undef PG8_WAIT_L
#undef PG8_BAR
#undef PG8_SCHED
}
}
#ifndef DBLMASK
#define DBLMASK 0
#endif
#ifndef PG8_SP2
#define PG8_SP2 true
#endif
#ifndef PG8_ALIGN
#define PG8_ALIGN true
#endif

constexpr int NWAVES = 8;
constexpr int D_MODEL = 4096, BATCH = 4, SEQ = 4096, DEPTH = 4, N_META = 16, LSEQ = N_META + SEQ  ;
constexpr int MMAIN = BATCH * SEQ  , NMETA_ROWS = BATCH * N_META  , MP = MMAIN + NMETA_ROWS  , MPA = MMAIN + 256  ;
constexpr int HEADS = 16, NOPE = 128, ROPE = 64, QKD = 192, VD = 128, MLAW = 2048, QLORA = 1024, KVLORA = 512, POOLW = 2048;
constexpr int IN_WIDTH = 15936, NIN = 16128;
constexpr int PC_CQ = 0, PC_CKV = 1024, PC_U = 1536, PC_GA = 3584, PC_GB = 5632, PC_MA = 7680, PC_MB = 11776, PC_KR = 15872;
constexpr int LP = 4160;
constexpr float NORM_EPS = 1e-6f;

constexpr size_t al256(size_t x) { return (x + 255) / 256 * 256; }
constexpr size_t WS_CTL = 0, CTL_ZERO_BYTES = 1u << 20;
constexpr size_t WS_TAB = CTL_ZERO_BYTES;
constexpr size_t WS_W = WS_TAB + al256((size_t)LSEQ * 32 * 8);
constexpr size_t WL_IN = 0, WL_UQ = WL_IN + (size_t)NIN * 4096 * 2, WL_UKV = WL_UQ + (size_t)3072 * 1024 * 2, WL_POOL = WL_UKV + (size_t)4096 * 512 * 2,
                 WL_AB = WL_POOL + (size_t)2048 * 512 * 2, WL_OUT = WL_AB + (size_t)4096 * 4096 * 2, WL_SIZE = WL_OUT + (size_t)4096 * 4096 * 2;
constexpr size_t WS_SS = WS_W + DEPTH * WL_SIZE;
constexpr size_t WS_PART = WS_SS + al256((size_t)2 * MPA * 4);
constexpr size_t WS_PARTM = WS_PART + 64 * 256 * 4;
constexpr size_t WS_H = WS_PARTM + (size_t)64 * 16384 * 4;
constexpr size_t WS_HN = WS_H + (size_t)MPA * 4096 * 4;
constexpr size_t WS_PROJ = WS_HN + (size_t)MPA * 4096 * 2;
constexpr size_t WS_PARTQ = WS_PROJ + (size_t)MPA * NIN * 2;
constexpr size_t WS_SSQ = WS_PARTQ + (size_t)24 * MPA * 4;
constexpr size_t WS_CKVN = WS_SSQ + (size_t)2 * MPA * 4;
constexpr size_t WS_DIFF = WS_CKVN + (size_t)MP * 512 * 2;
constexpr size_t WS_QRAW = WS_DIFF + (size_t)MP * 2048 * 2;
constexpr size_t WS_KRAW = WS_QRAW + (size_t)MP * 3072 * 2;
constexpr size_t WS_KA = WS_KRAW + (size_t)MP * 2048 * 2;
constexpr size_t WS_VA = WS_KA + (size_t)64 * LP * 192 * 2;
constexpr size_t WS_XAB = WS_VA + (size_t)64 * LP * 128 * 2;
constexpr size_t WS_T1 = WS_XAB + (size_t)MP * 4096 * 2;
constexpr size_t WS_MG = WS_T1 + (size_t)MP * 4096 * 2;
constexpr size_t WS_END = WS_MG + (size_t)MP * 4096 * 2 + 65536;
constexpr int CW_TMO = 0, CW_BAR = 4096, CW_ARR = 8192;

constexpr int RING_OFF = 0, RING_BYTES = 131072, LDSCTL_OFF = RING_BYTES, MISC_OFF = LDSCTL_OFF + 320, LDS_BYTES = 147456;

#define GAS __attribute__((address_space(1)))
#define LAS __attribute__((address_space(3)))
typedef unsigned short bf16;
typedef unsigned v4u __attribute__((ext_vector_type(4)));
typedef unsigned v2u __attribute__((ext_vector_type(2)));
typedef float f32x4 __attribute__((ext_vector_type(4)));
typedef short bf16x8 __attribute__((ext_vector_type(8)));
typedef short s16x4 __attribute__((ext_vector_type(4)));
typedef float f32x16 __attribute__((ext_vector_type(16)));
#define LDS_WAIT() asm volatile("s_waitcnt lgkmcnt(0)" ::: "memory")
#define VM_WAIT() asm volatile("s_waitcnt vmcnt(0)" ::: "memory")
#define WG_BAR() do { asm volatile("s_waitcnt lgkmcnt(0)" ::: "memory"); __builtin_amdgcn_s_barrier(); asm volatile("" ::: "memory"); } while (0)
__device__ __forceinline__ unsigned cvtpk(float lo, float hi) { unsigned r; asm volatile("v_cvt_pk_bf16_f32 %0, %1, %2" : "=v"(r) : "v"(lo), "v"(hi)); return r; }
__device__ __forceinline__ float bflo(unsigned u) { return __uint_as_float(u << 16); }
__device__ __forceinline__ float bfhi(unsigned u) { return __uint_as_float(u & 0xffff0000u); }
__device__ __forceinline__ float wave_sum(float v) {
#pragma unroll
    for (int o = 1; o < 64; o <<= 1) v += __shfl_xor(v, o);
    return v;
}

__device__ __forceinline__ void row_bp(int m, int& b, int& pos) { if (m < MMAIN) { b = m >> 12; pos = N_META + (m & 4095); } else { const int j = m - MMAIN; b = j >> 4; pos = j & 15; } }
__device__ __forceinline__ int row_of(int b, int pos) { return pos >= N_META ? b * SEQ + pos - N_META : MMAIN + b * N_META + pos; }

#define XB_TMO      128
#define XB_XCNT(j)  (256  + 64 * (j))
#define XB_XSUB(j)  (1280 + 64 * (j))
#define XB_XGEN(j)  (2304 + 64 * (j))
#define XB_TOP      3328
#define XB_TOPGEN   3392
#define XCD_BAR_WORDS 3456
#define XB_SPIN_CAP (1u << 18)
__device__ __forceinline__ unsigned xb_ld(unsigned* p)              { return __hip_atomic_load(p, __ATOMIC_RELAXED, __HIP_MEMORY_SCOPE_AGENT); }
__device__ __forceinline__ unsigned xb_add(unsigned* p, unsigned v) { return __hip_atomic_fetch_add(p, v, __ATOMIC_RELAXED, __HIP_MEMORY_SCOPE_AGENT); }
__device__ __forceinline__ unsigned xb_xcc_id() { return (unsigned)__builtin_amdgcn_s_getreg((3 << 11) | 20) & 0xFu; }
#define XB_SPIN(cond, bar) do { unsigned _sp = 0; while (cond) { __builtin_amdgcn_s_sleep(1); \
    if ((++_sp & 255u) == 0u) { if (xb_ld(&(bar)[XB_TMO])) break; if (_sp > XB_SPIN_CAP) { atomicAdd(&(bar)[XB_TMO], 1u); break; } } } } while (0)
struct XcdBarrier { unsigned* bar; unsigned x; volatile LAS unsigned* st; };
__device__ __forceinline__ XcdBarrier xcd_barrier_post(unsigned* bar, volatile LAS unsigned* st) {
    XcdBarrier b; b.bar = bar; b.x = xb_xcc_id(); b.st = st;
    if (threadIdx.x == 0) (void)xb_add(&bar[XB_XCNT(b.x)], 1u);
    return b;
}
__device__ __forceinline__ void xcd_barrier_complete(unsigned* bar, unsigned x, unsigned& nloc, unsigned& nx) {
    const unsigned G = gridDim.x * gridDim.y * gridDim.z;
    unsigned sum, cnt, mine, sp = 0u;
    for (;;) {
        sum = 0u; cnt = 0u; mine = 0u;
#pragma unroll
        for (unsigned j = 0; j < 16; ++j) { const unsigned c = xb_ld(&bar[XB_XCNT(j)]); sum += c; cnt += (c > 0u) ? 1u : 0u; mine = (j == x) ? c : mine; }
        if (sum == G) break;
        __builtin_amdgcn_s_sleep(1);
        if ((++sp & 255u) == 0u) { if (xb_ld(&bar[XB_TMO])) break; if (sp > XB_SPIN_CAP) { atomicAdd(&bar[XB_TMO], 1u); break; } }
    }
    nloc = mine > 0u ? mine : 1u; nx = cnt > 0u ? cnt : 1u;
}
__device__ __forceinline__ void xcd_barrier(const XcdBarrier& b) {
    asm volatile("s_waitcnt vmcnt(0)" ::: "memory");
    __syncthreads();
    if (threadIdx.x == 0) {
        unsigned* bar = b.bar;
        const unsigned bx = xb_xcc_id();
        __builtin_amdgcn_s_waitcnt(0);
        unsigned nloc = b.st[0], nx = b.st[1];
        if (nloc == 0u) { xcd_barrier_complete(bar, bx, nloc, nx); b.st[0] = nloc; b.st[1] = nx; }
        const unsigned old = xb_add(&bar[XB_XSUB(bx)], 1u);
        const unsigned gen = old / nloc;
        if (old + 1u == (gen + 1u) * nloc) {
            __builtin_amdgcn_fence(__ATOMIC_RELEASE, "agent");
            asm volatile("s_waitcnt vmcnt(0)" ::: "memory");
            const unsigned og = xb_add(&bar[XB_TOP], 1u);
            const unsigned tg = og / nx;
            if (og + 1u == (tg + 1u) * nx) xb_add(&bar[XB_TOPGEN], 1u);
            else XB_SPIN(xb_ld(&bar[XB_TOPGEN]) == tg, bar);
            __builtin_amdgcn_fence(__ATOMIC_ACQUIRE, "agent");
            xb_add(&bar[XB_XGEN(bx)], 1u);
            asm volatile("s_waitcnt vmcnt(0)" ::: "memory");
        } else {
            XB_SPIN(xb_ld(&bar[XB_XGEN(bx)]) == gen, bar);
            __builtin_amdgcn_fence(__ATOMIC_ACQUIRE, "agent");
            asm volatile("s_waitcnt vmcnt(0)" ::: "memory");
        }
    }
    __syncthreads();
}

struct Frame {
    LAS unsigned char* lds;
    int tid, lane, wave, vcu, G;
    unsigned char* ws;
    const float* in[15];
    float* out;
};
enum { I_X = 0, I_META, I_NORMG, I_WIN, I_QLG, I_KVLG, I_WUQ, I_WUKV, I_QHG, I_KHG, I_WPOOL, I_PSCALE, I_WA, I_WB, I_WOUT };

__device__ __forceinline__ void tr_item(const float* W, int ldw, int k0, int nsrc0, bf16* WT, int ldt, int ndst0, int kdst0, LAS float* scr, int lane, const float* ks = nullptr) {
#pragma unroll 8
    for (int i = 0; i < 32; ++i) { const int kk = 2 * i + (lane >> 5); scr[kk * 33 + (lane & 31)] = W[(size_t)(k0 + kk) * ldw + nsrc0 + (lane & 31)]; }
    const int c = lane & 7;
    f32x4 sa = {1.f, 1.f, 1.f, 1.f}, sb = sa; if (ks) { sa = *(const GAS f32x4*)(ks + k0 + 8 * c); sb = *(const GAS f32x4*)(ks + k0 + 8 * c + 4); }
    LDS_WAIT(); asm volatile("" ::: "memory");
#pragma unroll
    for (int j = 0; j < 4; ++j) { const int n = (lane >> 3) + 8 * j; const LAS float* s = scr + (8 * c) * 33 + n;
        v4u o; o.x = cvtpk(s[0 * 33] * sa.x, s[1 * 33] * sa.y); o.y = cvtpk(s[2 * 33] * sa.z, s[3 * 33] * sa.w); o.z = cvtpk(s[4 * 33] * sb.x, s[5 * 33] * sb.y); o.w = cvtpk(s[6 * 33] * sb.z, s[7 * 33] * sb.w);
        *(GAS v4u*)(WT + (size_t)(ndst0 + n) * ldt + kdst0 + k0 + 8 * c) = o; }
    LDS_WAIT(); asm volatile("" ::: "memory");
}
constexpr int IT_IN = 64 * (NIN / 32), IT_UQ = 16 * 96, IT_UKV = 8 * 128, IT_POOL = 4 * 8 * 16, IT_A = 32 * 128, IT_B = 32 * 128, IT_OUT = 64 * 128;
constexpr int IT_LAYER = IT_IN + IT_UQ + IT_UKV + IT_POOL + IT_A + IT_B + IT_OUT;
__device__ __forceinline__ void p0_prologue(Frame& F0) {
    struct { LAS unsigned char* lds; int tid, lane, wave, vcu, G; unsigned char* ws; const float* const* in; } F;
    F.lds = F0.lds; F.tid = F0.tid; asm volatile("" : "+v"(F.tid)); F.lane = F.tid & 63; F.wave = F0.wave; F.vcu = F0.vcu; F.G = F0.G; F.ws = F0.ws; F.in = F0.in;
    LAS float* scr = (LAS float*)(F.lds + RING_OFF + F.wave * 16384);
    const int gw = F.vcu * NWAVES + F.wave, NGW = F.G * NWAVES;
    for (int it = gw; it < DEPTH * IT_LAYER; it += NGW) {
        const int l = it / IT_LAYER; int r = it - l * IT_LAYER;
        bf16* wl = (bf16*)(F.ws + WS_W + (size_t)l * WL_SIZE);
        if (r < IT_IN) { const int kb = r / (NIN / 32), nb = r - kb * (NIN / 32), nd = nb * 32, k0 = kb * 64;
            bf16* WT = (bf16*)((unsigned char*)wl + WL_IN);
            if (nd >= IN_WIDTH) {
#pragma unroll
                for (int j = 0; j < 4; ++j) { const int q = j * 64 + F.lane, n = q >> 3, c = q & 7; *(GAS v4u*)(WT + (size_t)(nd + n) * 4096 + k0 + 8 * c) = (v4u){0u, 0u, 0u, 0u}; }
            } else { int ns;
                if (nd < 1536) ns = nd; else if (nd < PC_MA) ns = nd + 64; else if (nd < PC_KR) { const int rel = nd - PC_MA, t = rel >> 8, off = rel & 255; ns = (off < 128 ? 7744 : 11840) + 128 * t + (off & 127); } else ns = nd - PC_KR + 1536;
                tr_item(F.in[I_WIN] + (size_t)l * 4096 * IN_WIDTH, IN_WIDTH, k0, ns, WT, 4096, nd, 0, scr, F.lane, F.in[I_NORMG] + (size_t)l * 4096); }
            continue; }
        r -= IT_IN;
        if (r < IT_UQ) { const int kb = r / 96, nb = r - kb * 96; tr_item(F.in[I_WUQ] + (size_t)l * 1024 * 3072, 3072, kb * 64, nb * 32, (bf16*)((unsigned char*)wl + WL_UQ), 1024, nb * 32, 0, scr, F.lane, F.in[I_QLG] + (size_t)l * 1024); continue; }
        r -= IT_UQ;
        if (r < IT_UKV) { const int kb = r / 128, nb = r - kb * 128; tr_item(F.in[I_WUKV] + (size_t)l * 512 * 4096, 4096, kb * 64, nb * 32, (bf16*)((unsigned char*)wl + WL_UKV), 512, nb * 32, 0, scr, F.lane, F.in[I_KVLG] + (size_t)l * 512); continue; }
        r -= IT_UKV;
        if (r < IT_POOL) { const int g = r / 128, rr = r - g * 128, kb = rr / 16, nb = rr - kb * 16;
            tr_item(F.in[I_WPOOL] + ((size_t)l * 4 + g) * 512 * 512, 512, kb * 64, nb * 32, (bf16*)((unsigned char*)wl + WL_POOL), 512, g * 512 + nb * 32, 0, scr, F.lane); continue; }
        r -= IT_POOL;
        if (r < IT_A) { const int kb = r / 128, nb = r - kb * 128; tr_item(F.in[I_WA] + (size_t)l * 2048 * 4096, 4096, kb * 64, nb * 32, (bf16*)((unsigned char*)wl + WL_AB), 4096, nb * 32, 0, scr, F.lane); continue; }
        r -= IT_A;
        if (r < IT_B) { const int kb = r / 128, nb = r - kb * 128; tr_item(F.in[I_WB] + (size_t)l * 2048 * 4096, 4096, kb * 64, nb * 32, (bf16*)((unsigned char*)wl + WL_AB), 4096, nb * 32, 2048, scr, F.lane); continue; }
        r -= IT_B;
        { const int kb = r / 128, nb = r - kb * 128; tr_item(F.in[I_WOUT] + (size_t)l * 4096 * 4096, 4096, kb * 64, nb * 32, (bf16*)((unsigned char*)wl + WL_OUT), 4096, nb * 32, 0, scr, F.lane); }
    }
    const size_t gt = (size_t)(F.vcu) * (NWAVES * 64) + F.tid, NT = (size_t)F.G * NWAVES * 64;
    { bf16* HG = (bf16*)(F.ws + WS_HN); float* SS = (float*)(F.ws + WS_SS);
      for (int m = gw; m < MP; m += NGW) {
          const float* src = m < MMAIN ? F.in[I_X] + (size_t)m * 4096 : F.in[I_META] + (size_t)((m - MMAIN) & 15) * 4096;
          const GAS f32x4* xr = (const GAS f32x4*)src + F.lane; GAS v2u* o = (GAS v2u*)(HG + (size_t)m * 4096) + F.lane;
          float ss = 0.f;
#pragma unroll 4
          for (int j = 0; j < 16; ++j) { const f32x4 v = xr[64 * j]; ss += (v.x * v.x + v.y * v.y) + (v.z * v.z + v.w * v.w);
              v2u w; w.x = cvtpk(v.x, v.y); w.y = cvtpk(v.z, v.w); o[64 * j] = w; }
          ss = wave_sum(ss); if (F.lane == 0) SS[m] = ss; } }
    { float* TAB = (float*)(F.ws + WS_TAB);
      for (size_t i = gt; i < (size_t)LSEQ * 32; i += NT) { const int pos = (int)(i >> 5), fi = (int)(i & 31);
          const float inv = 1.0f / powf(10000.0f, (float)fi * (1.0f / 32.0f)); const float ang = (float)pos * inv;
          double rev = (double)ang * 0.15915494309189533577; rev -= rint(rev); const float rv = (float)rev;
          TAB[2 * i] = __builtin_amdgcn_cosf(rv); TAB[2 * i + 1] = __builtin_amdgcn_sinf(rv); } }
    { bf16* HB = (bf16*)(F.ws + WS_HN); for (size_t i = gt; i < (size_t)(MPA - MP) * 512; i += NT) *(GAS v4u*)(HB + (size_t)MP * 4096 + i * 8) = (v4u){0u, 0u, 0u, 0u}; }
    { bf16* KA = (bf16*)(F.ws + WS_KA); bf16* VA = (bf16*)(F.ws + WS_VA);
      for (size_t i = gt; i < (size_t)64 * 48 * 24; i += NT) { const int bh = (int)(i / (48 * 24)), rr = (int)(i % (48 * 24)); *(GAS v4u*)(KA + ((size_t)bh * LP + 16) * 192 + rr * 8) = (v4u){0u, 0u, 0u, 0u}; }
      for (size_t i = gt; i < (size_t)64 * 48 * 16; i += NT) { const int bh = (int)(i / (48 * 16)), rr = (int)(i % (48 * 16)); *(GAS v4u*)(VA + ((size_t)bh * LP + 16) * 128 + rr * 8) = (v4u){0u, 0u, 0u, 0u}; } }
}

__device__ __forceinline__ void unpack8(const v4u& u, float (&f)[8]) { f[0] = bflo(u.x); f[1] = bfhi(u.x); f[2] = bflo(u.y); f[3] = bfhi(u.y); f[4] = bflo(u.z); f[5] = bfhi(u.z); f[6] = bflo(u.w); f[7] = bfhi(u.w); }
constexpr int P3_RUNL = 9, P3_NRUN = (LSEQ + P3_RUNL - 1) / P3_RUNL;
template <int J> __device__ __forceinline__ void p3_load(const bf16* PROJ, int b, int p0, int lane, v4u (&r)[(2 << J) - 1 + P3_RUNL]) {
    constexpr int W = 2 << J, NR = W - 1 + P3_RUNL; const int c = (J * 64 + lane) * 8;
#pragma unroll
    for (int i = 0; i < NR; ++i) { int pos = p0 - (W - 1) + i; pos = pos < 0 ? 0 : (pos > LSEQ - 1 ? LSEQ - 1 : pos); r[i] = *(const GAS v4u*)(PROJ + (size_t)row_of(b, pos) * NIN + PC_U + c); }
}
template <int J> __device__ __forceinline__ void p3_slide(bf16* DIFF, int b, int p0, int lane, const v4u (&r)[(2 << J) - 1 + P3_RUNL]) {
    constexpr int W = 2 << J; const int c = (J * 64 + lane) * 8;
    float S[8];
#pragma unroll
    for (int e = 0; e < 8; ++e) S[e] = 0.f;
#pragma unroll
    for (int i = 0; i < W - 1; ++i) { float t[8]; unpack8(r[i], t); const float keep = p0 - (W - 1) + i >= 0 ? 1.0f : 0.0f;
#pragma unroll
        for (int e = 0; e < 8; ++e) S[e] += keep * t[e]; }
#pragma unroll
    for (int q = 0; q < P3_RUNL; ++q) { const int p = p0 + q; float x[8], t[8], d[8]; unpack8(r[W - 1 + q], x); unpack8(r[q], t);
        const int n = p + 1 < W ? p + 1 : W; const float rn = 1.0f / (float)n; const float drop = (p - W + 1 >= 0) ? 1.0f : 0.0f;
#pragma unroll
        for (int e = 0; e < 8; ++e) { S[e] += x[e]; d[e] = S[e] * rn - x[e]; S[e] -= drop * t[e]; }
        v4u o; o.x = cvtpk(d[0], d[1]); o.y = cvtpk(d[2], d[3]); o.z = cvtpk(d[4], d[5]); o.w = cvtpk(d[6], d[7]);
        if (p < LSEQ) *(GAS v4u*)(DIFF + (size_t)row_of(b, p) * 2048 + c) = o; }
}
__device__ __forceinline__ void p3_latent(Frame& F0, const float* qg, const float* kvg, float* ssn) {
    struct { int lane, wave, vcu, G; unsigned char* ws; } F; F.lane = F0.lane; asm volatile("" : "+v"(F.lane)); F.wave = F0.wave; F.vcu = F0.vcu; F.G = F0.G; F.ws = F0.ws;
    const bf16* PROJ = (const bf16*)(F.ws + WS_PROJ); bf16* DIFF = (bf16*)(F.ws + WS_DIFF);
    if (F.wave == NWAVES - 1) { const float* PARTQ = (const float*)(F.ws + WS_PARTQ); float* SSQ = (float*)(F.ws + WS_SSQ);
      for (int i = F.lane; i < 65; i += 64) { const int m = F.vcu * 65 + i; if (m < MP) { float v[24];
#pragma unroll
          for (int k = 0; k < 24; ++k) v[k] = PARTQ[(size_t)k * MPA + m];
          float sq = 0.f, skv = 0.f;
#pragma unroll
          for (int k = 0; k < 16; ++k) sq += v[k];
#pragma unroll
          for (int k = 16; k < 24; ++k) skv += v[k];
          SSQ[m] = sq; SSQ[MPA + m] = skv; } } }
    for (int run = F.wave * F.G + F.vcu; run < BATCH * P3_NRUN; run += F.G * NWAVES) {
        const int b = run / P3_NRUN, p0 = (run - b * P3_NRUN) * P3_RUNL;
        { v4u r0[1 + P3_RUNL], r1[3 + P3_RUNL], r2[7 + P3_RUNL];
          p3_load<0>(PROJ, b, p0, F.lane, r0); p3_load<1>(PROJ, b, p0, F.lane, r1); p3_load<2>(PROJ, b, p0, F.lane, r2);
          __builtin_amdgcn_sched_barrier(0);
          p3_slide<0>(DIFF, b, p0, F.lane, r0); p3_slide<1>(DIFF, b, p0, F.lane, r1); p3_slide<2>(DIFF, b, p0, F.lane, r2); }
        __builtin_amdgcn_sched_barrier(0);
        { v4u r3[15 + P3_RUNL];
          p3_load<3>(PROJ, b, p0, F.lane, r3);
          __builtin_amdgcn_sched_barrier(0);
          p3_slide<3>(DIFF, b, p0, F.lane, r3); }
    }
}

__device__ __forceinline__ void p5_knorm(Frame& F0, const float* khg) {
    struct { int lane, wave, vcu, G; unsigned char* ws; } F; F.lane = F0.lane; asm volatile("" : "+v"(F.lane)); F.wave = F0.wave; F.vcu = F0.vcu; F.G = F0.G; F.ws = F0.ws;
    const int gw = F.vcu * NWAVES + F.wave, NGW = F.G * NWAVES;
    const bf16* PROJ = (const bf16*)(F.ws + WS_PROJ); const bf16* KRAW = (const bf16*)(F.ws + WS_KRAW);
    bf16* KA = (bf16*)(F.ws + WS_KA); const float* TAB = (const float*)(F.ws + WS_TAB);
    const int l = F.lane, cn = 8 * (l & 15), hr = l >> 2, c0 = 16 * (l & 3), cp = c0 ^ 32, fi = c0 & 31;
    float gn[8], go[16], gp[16];
#pragma unroll
    for (int e = 0; e < 8; ++e) gn[e] = khg[cn + e];
#pragma unroll
    for (int e = 0; e < 16; ++e) { go[e] = khg[128 + c0 + e]; gp[e] = khg[128 + cp + e]; }
    for (int m = gw; m < MP; m += NGW) {
        int b, pos; row_bp(m, b, pos); const int pp = pos < N_META ? pos : pos + 48;
        const bf16* kr = PROJ + (size_t)m * NIN + PC_KR;
        v4u xr[4], krs, ka0, ka1, kp0, kp1; f32x4 tbv[8];
#pragma unroll
        for (int j = 0; j < 4; ++j) xr[j] = *(const GAS v4u*)(KRAW + (size_t)m * 2048 + 512 * j + 8 * l);
        krs = *(const GAS v4u*)(kr + 8 * (l & 7)); ka0 = *(const GAS v4u*)(kr + c0); ka1 = *(const GAS v4u*)(kr + c0 + 8); kp0 = *(const GAS v4u*)(kr + cp); kp1 = *(const GAS v4u*)(kr + cp + 8);
        { const GAS f32x4* tb = (const GAS f32x4*)(TAB + ((size_t)pos * 32 + fi) * 2);
#pragma unroll
          for (int q = 0; q < 8; ++q) tbv[q] = tb[q]; }
        __builtin_amdgcn_sched_barrier(0);
        float x[4][8], ssn[4];
#pragma unroll
        for (int j = 0; j < 4; ++j) { unpack8(xr[j], x[j]); float sv = 0.f;
#pragma unroll
            for (int e = 0; e < 8; ++e) sv += x[j][e] * x[j][e];
            sv += __shfl_xor(sv, 1); sv += __shfl_xor(sv, 2); sv += __shfl_xor(sv, 4); sv += __shfl_xor(sv, 8); ssn[j] = sv; }
        float sk;
        { float t[8]; unpack8(krs, t); sk = 0.f;
#pragma unroll
          for (int e = 0; e < 8; ++e) sk += t[e] * t[e];
          sk += __shfl_xor(sk, 1); sk += __shfl_xor(sk, 2); sk += __shfl_xor(sk, 4); }
        float r[4];
#pragma unroll
        for (int j = 0; j < 4; ++j) { r[j] = 1.0f / sqrtf((ssn[j] + sk) * (1.0f / 192.0f) + NORM_EPS);
            v4u w; w.x = cvtpk(x[j][0] * r[j] * gn[0], x[j][1] * r[j] * gn[1]); w.y = cvtpk(x[j][2] * r[j] * gn[2], x[j][3] * r[j] * gn[3]);
            w.z = cvtpk(x[j][4] * r[j] * gn[4], x[j][5] * r[j] * gn[5]); w.w = cvtpk(x[j][6] * r[j] * gn[6], x[j][7] * r[j] * gn[7]);
            *(GAS v4u*)(KA + ((size_t)(b * 16 + (l >> 4) + 4 * j) * LP + pp) * 192 + cn) = w; }
        float rr;
        { const int src = 16 * (hr & 3); const float r0 = __shfl(r[0], src), r1 = __shfl(r[1], src), r2 = __shfl(r[2], src), r3 = __shfl(r[3], src); const int jj = hr >> 2;
          rr = jj == 0 ? r0 : (jj == 1 ? r1 : (jj == 2 ? r2 : r3)); }
        float xo[16], xp[16];
        { float t0[8], t1[8]; unpack8(ka0, t0); unpack8(ka1, t1);
#pragma unroll
          for (int e = 0; e < 8; ++e) { xo[e] = t0[e] * rr * go[e]; xo[8 + e] = t1[e] * rr * go[8 + e]; }
          unpack8(kp0, t0); unpack8(kp1, t1);
#pragma unroll
          for (int e = 0; e < 8; ++e) { xp[e] = t0[e] * rr * gp[e]; xp[8 + e] = t1[e] * rr * gp[8 + e]; } }
        const float sgn = (l & 2) ? 1.0f : -1.0f;
        float y[16];
#pragma unroll
        for (int q = 0; q < 8; ++q) { const f32x4 cs = tbv[q]; y[2 * q] = xo[2 * q] * cs.x + sgn * xp[2 * q] * cs.y; y[2 * q + 1] = xo[2 * q + 1] * cs.z + sgn * xp[2 * q + 1] * cs.w; }
        bf16* dst = KA + ((size_t)(b * 16 + hr) * LP + pp) * 192 + 128 + c0;
        v4u w0, w1; w0.x = cvtpk(y[0], y[1]); w0.y = cvtpk(y[2], y[3]); w0.z = cvtpk(y[4], y[5]); w0.w = cvtpk(y[6], y[7]); w1.x = cvtpk(y[8], y[9]); w1.y = cvtpk(y[10], y[11]); w1.z = cvtpk(y[12], y[13]); w1.w = cvtpk(y[14], y[15]);
        *(GAS v4u*)dst = w0; *(GAS v4u*)(dst + 8) = w1;
    }
}

namespace att {
constexpr int KROW = 400, SHM_K = 64 * KROW, SHM_V = 64 * 128 * 2;
constexpr int OFF_V = 0, OFF_K = 2 * SHM_V, OFF_WS = OFF_K + 2 * SHM_K, ATT_LDS = OFF_WS + NWAVES * 64 * 4;
static_assert(ATT_LDS <= RING_BYTES, "attention LDS");
constexpr float SCALE = 0.07216878364870322f;
__device__ __forceinline__ int crow(int r, int hi) { return (r & 3) + 8 * (r >> 2) + 4 * hi; }
__device__ __forceinline__ int v_st(int k, int c) { const int kk = (k & ~0xC) | ((k & 4) << 1) | ((k & 8) >> 1); return ((kk >> 3) * 4 + (c >> 5)) * 512 + ((kk & 7) * 32 + (c & 31)) * 2; }
__device__ __forceinline__ int v_rd_base(int lane) { return ((lane & 3) << 3) | (((lane >> 2) & 3) << 6) | (((lane >> 4) & 1) << 5) | (((lane >> 5) & 1) << 8); }
constexpr int v_rd_off(int d0, int ks, int half) { return d0 * 512 + ks * 4096 + half * 2048; }
template <int OFF> __device__ __forceinline__ s16x4 tr_read(int vb) { s16x4 r; asm volatile("ds_read_b64_tr_b16 %0, %1 offset:%2" : "=&v"(r) : "v"(vb), "i"(OFF) : "memory"); return r; }
template <int D0> __device__ __forceinline__ void pv_one(f32x16& od, int vb, bf16x8 pa0, bf16x8 pa1, bf16x8 pa2, bf16x8 pa3) {
    const s16x4 l0 = tr_read<v_rd_off(D0, 0, 0)>(vb), h0 = tr_read<v_rd_off(D0, 0, 1)>(vb), l1 = tr_read<v_rd_off(D0, 1, 0)>(vb), h1 = tr_read<v_rd_off(D0, 1, 1)>(vb);
    const s16x4 l2 = tr_read<v_rd_off(D0, 2, 0)>(vb), h2 = tr_read<v_rd_off(D0, 2, 1)>(vb), l3 = tr_read<v_rd_off(D0, 3, 0)>(vb), h3 = tr_read<v_rd_off(D0, 3, 1)>(vb);
    asm volatile("s_waitcnt lgkmcnt(0)" ::: "memory"); __builtin_amdgcn_sched_barrier(0);
#define PK(L, H) (bf16x8){L[0], L[1], L[2], L[3], H[0], H[1], H[2], H[3]}
    od = __builtin_amdgcn_mfma_f32_32x32x16_bf16(pa0, PK(l0, h0), od, 0, 0, 0);
    od = __builtin_amdgcn_mfma_f32_32x32x16_bf16(pa1, PK(l1, h1), od, 0, 0, 0);
    od = __builtin_amdgcn_mfma_f32_32x32x16_bf16(pa2, PK(l2, h2), od, 0, 0, 0);
    od = __builtin_amdgcn_mfma_f32_32x32x16_bf16(pa3, PK(l3, h3), od, 0, 0, 0);
#undef PK
}
template <int VAR>
__device__ __forceinline__ void attn_unit(const bf16* Qraw, const float* qhg, const float* TAB, int pos0, const bf16* Kh, const bf16* Vh, int NT, int lw, bf16* XA, const bf16* GA, int m0, int nrows_out, LAS unsigned char* lds) {
    int tid = threadIdx.x; asm volatile("" : "+v"(tid));
    const int wid = __builtin_amdgcn_readfirstlane(tid >> 6), lane = tid & 63, r32 = lane & 31, hi = lane >> 5;
    LAS unsigned char* V_lds = lds + OFF_V; LAS unsigned char* K_lds = lds + OFF_K;
    LAS float* wsf = (LAS float*)(lds + OFF_WS) + wid * 64; LAS float* li_l = wsf; LAS float* al_l = wsf + 32;
    float l_reg = 0.f; f32x16 o[4], negm;
#pragma unroll
    for (int r = 0; r < 16; ++r) negm[r] = 0.f;
#pragma unroll
    for (int d = 0; d < 4; ++d)
#pragma unroll
        for (int r = 0; r < 16; ++r) o[d][r] = 0.f;
    bf16x8 qr[12];
    { const int ri = wid * 32 + r32, rc = ri < nrows_out ? ri : nrows_out - 1;
      const bf16* Qw = Qraw + (size_t)(m0 + rc) * 3072 + hi * 8;
      v4u raw[12]; const int pos = pos0 + rc;
#pragma unroll
      for (int d0 = 0; d0 < 12; ++d0) raw[d0] = *(const GAS v4u*)(Qw + d0 * 16);
      f32x4 tbv[2][4];
#pragma unroll
      for (int dd = 0; dd < 2; ++dd)
#pragma unroll
          for (int q = 0; q < 4; ++q) tbv[dd][q] = *((const GAS f32x4*)(TAB + ((size_t)pos * 32 + dd * 16 + hi * 8) * 2) + q);
      __builtin_amdgcn_sched_barrier(0);
      float ss = 0.f;
#pragma unroll
      for (int d0 = 0; d0 < 12; ++d0) { float t[8]; unpack8(raw[d0], t);
#pragma unroll
          for (int e = 0; e < 8; ++e) ss += t[e] * t[e]; }
      ss += __shfl_xor(ss, 32);
      const float rq = (SCALE * 1.4426950408889634f) / sqrtf(ss * (1.0f / 192.0f) + NORM_EPS);
#pragma unroll
      for (int dh = 0; dh < 2; ++dh) {
          f32x4 g0[4], g1[4];
#pragma unroll
          for (int k = 0; k < 4; ++k) { const int d0 = 4 * dh + k; g0[k] = *(const GAS f32x4*)(qhg + d0 * 16 + hi * 8); g1[k] = *(const GAS f32x4*)(qhg + d0 * 16 + hi * 8 + 4); }
          __builtin_amdgcn_sched_barrier(0);
#pragma unroll
          for (int k = 0; k < 4; ++k) { const int d0 = 4 * dh + k; float t[8]; unpack8(raw[d0], t);
              v4u w; w.x = cvtpk(t[0] * rq * g0[k].x, t[1] * rq * g0[k].y); w.y = cvtpk(t[2] * rq * g0[k].z, t[3] * rq * g0[k].w); w.z = cvtpk(t[4] * rq * g1[k].x, t[5] * rq * g1[k].y); w.w = cvtpk(t[6] * rq * g1[k].z, t[7] * rq * g1[k].w);
              qr[d0] = *reinterpret_cast<bf16x8*>(&w); } }
      f32x4 ga[2][2], gb[2][2];
#pragma unroll
      for (int dd = 0; dd < 2; ++dd) { ga[dd][0] = *(const GAS f32x4*)(qhg + 128 + dd * 16 + hi * 8); ga[dd][1] = *(const GAS f32x4*)(qhg + 128 + dd * 16 + hi * 8 + 4);
          gb[dd][0] = *(const GAS f32x4*)(qhg + 160 + dd * 16 + hi * 8); gb[dd][1] = *(const GAS f32x4*)(qhg + 160 + dd * 16 + hi * 8 + 4); }
      __builtin_amdgcn_sched_barrier(0);
#pragma unroll
      for (int dd = 0; dd < 2; ++dd) {
          float x1[8], x2[8]; unpack8(raw[8 + dd], x1); unpack8(raw[10 + dd], x2);
          const f32x4 a0 = ga[dd][0], a1 = ga[dd][1], b0 = gb[dd][0], b1 = gb[dd][1];
          const float g1v[8] = {a0.x, a0.y, a0.z, a0.w, a1.x, a1.y, a1.z, a1.w}, g2v[8] = {b0.x, b0.y, b0.z, b0.w, b1.x, b1.y, b1.z, b1.w};
          float y1[8], y2[8];
#pragma unroll
          for (int q = 0; q < 4; ++q) { const f32x4 cs = tbv[dd][q];
              const float u0 = x1[2 * q] * rq * g1v[2 * q], v0 = x2[2 * q] * rq * g2v[2 * q], u1 = x1[2 * q + 1] * rq * g1v[2 * q + 1], v1 = x2[2 * q + 1] * rq * g2v[2 * q + 1];
              y1[2 * q] = u0 * cs.x - v0 * cs.y; y2[2 * q] = v0 * cs.x + u0 * cs.y; y1[2 * q + 1] = u1 * cs.z - v1 * cs.w; y2[2 * q + 1] = v1 * cs.z + u1 * cs.w; }
          v4u w1, w2; w1.x = cvtpk(y1[0], y1[1]); w1.y = cvtpk(y1[2], y1[3]); w1.z = cvtpk(y1[4], y1[5]); w1.w = cvtpk(y1[6], y1[7]);
          w2.x = cvtpk(y2[0], y2[1]); w2.y = cvtpk(y2[2], y2[3]); w2.z = cvtpk(y2[4], y2[5]); w2.w = cvtpk(y2[6], y2[7]);
          qr[8 + dd] = *reinterpret_cast<bf16x8*>(&w1); qr[10 + dd] = *reinterpret_cast<bf16x8*>(&w2); }
    }
    const int sr = tid >> 4, sc = (tid & 15) * 8, vst0 = v_st(sr, sc), vst1 = v_st(32 + sr, sc);
    unsigned kgo[3], klo[3];
#pragma unroll
    for (int i = 0; i < 3; ++i) { const int id = tid + 512 * i, kr_ = id / 24, kc_ = id - kr_ * 24; kgo[i] = (unsigned)(kr_ * (QKD * 2) + kc_ * 16); klo[i] = (unsigned)(kr_ * KROW + kc_ * 16); }
    const unsigned vgo0 = (unsigned)(sr * (VD * 2) + sc * 2), vgo1 = vgo0 + 32u * (VD * 2);
    const int vb0 = (int)(uintptr_t)(V_lds) + v_rd_base(lane);
    bf16x8 vs0, vs1, ks0, ks1, ks2;
    const GAS unsigned char* Kg = (const GAS unsigned char*)Kh; const GAS unsigned char* Vg = (const GAS unsigned char*)Vh;
#define SLOAD(k0) do { const GAS unsigned char* kt_ = Kg + (size_t)(k0) * (QKD * 2); const GAS unsigned char* vt_ = Vg + (size_t)(k0) * (VD * 2); \
        vs0 = *(const GAS bf16x8*)(vt_ + vgo0); vs1 = *(const GAS bf16x8*)(vt_ + vgo1); \
        ks0 = *(const GAS bf16x8*)(kt_ + kgo[0]); ks1 = *(const GAS bf16x8*)(kt_ + kgo[1]); ks2 = *(const GAS bf16x8*)(kt_ + kgo[2]); } while (0)
#define SWRITE(b) do { *(LAS bf16x8*)(V_lds + (b) * SHM_V + vst0) = vs0; *(LAS bf16x8*)(V_lds + (b) * SHM_V + vst1) = vs1; \
        *(LAS bf16x8*)(K_lds + (b) * SHM_K + klo[0]) = ks0; *(LAS bf16x8*)(K_lds + (b) * SHM_K + klo[1]) = ks1; *(LAS bf16x8*)(K_lds + (b) * SHM_K + klo[2]) = ks2; } while (0)
    constexpr float ATT_THR = 8.0f;
    SLOAD(0);
    for (int j = 0; j < NT; ++j) {
        const int buf = j & 1;
        if (VAR != 1) { asm volatile("s_waitcnt vmcnt(0)" ::: "memory");
        SWRITE(buf);
        if (j + 1 < NT) SLOAD((j + 1) * 64); }
        if (VAR != 5) WG_BAR();
        if (j <= lw) {
            f32x16 p0, p1;
            { const LAS unsigned char* Kb = K_lds + buf * SHM_K + r32 * KROW + hi * 16;
              { const bf16x8 b0 = *(const LAS bf16x8*)(Kb), b1 = *(const LAS bf16x8*)(Kb + 32 * KROW);
                p0 = __builtin_amdgcn_mfma_f32_32x32x16_bf16(b0, qr[0], negm, 0, 0, 0); p1 = __builtin_amdgcn_mfma_f32_32x32x16_bf16(b1, qr[0], negm, 0, 0, 0); }
#pragma unroll
              for (int d0 = 1; d0 < (VAR == 2 ? 1 : 12); ++d0) { const bf16x8 b0 = *(const LAS bf16x8*)(Kb + d0 * 32), b1 = *(const LAS bf16x8*)(Kb + 32 * KROW + d0 * 32);
                  p0 = __builtin_amdgcn_mfma_f32_32x32x16_bf16(b0, qr[d0], p0, 0, 0, 0); p1 = __builtin_amdgcn_mfma_f32_32x32x16_bf16(b1, qr[d0], p1, 0, 0, 0); } }
            if (j == 0) {
#pragma unroll
                for (int r = 8; r < 16; ++r) p0[r] = -1e30f;
#pragma unroll
                for (int r = 0; r < 16; ++r) p1[r] = -1e30f; }
            float pmax = p0[0];
#pragma unroll
            for (int r = 1; r < 16; ++r) pmax = fmaxf(pmax, p0[r]);
#pragma unroll
            for (int r = 0; r < 16; ++r) pmax = fmaxf(pmax, p1[r]);
            { auto rr = __builtin_amdgcn_permlane32_swap(__float_as_uint(pmax), __float_as_uint(pmax), false, false); pmax = fmaxf(__uint_as_float(rr[0]), __uint_as_float(rr[1])); }
            const bool grow = j == 0 || pmax > ATT_THR; float alpha = 1.0f;
            if (__any(grow)) { const float delta = grow ? pmax : 0.f; alpha = __builtin_amdgcn_exp2f(-delta);
#pragma unroll
                for (int r = 0; r < 16; ++r) { p0[r] -= delta; p1[r] -= delta; negm[r] -= delta; }
                if (VAR != 6) { if (hi == 0) al_l[r32] = alpha; asm volatile("s_waitcnt lgkmcnt(0)" ::: "memory");
#pragma unroll
                    for (int r = 0; r < 16; ++r) { const float a = al_l[crow(r, hi)];
#pragma unroll
                        for (int d = 0; d < 4; ++d) o[d][r] *= a; } } }
#pragma unroll
            for (int r = 0; r < 16; ++r) { p0[r] = __builtin_amdgcn_exp2f(p0[r]); p1[r] = __builtin_amdgcn_exp2f(p1[r]); }
            float ps = 0.f;
#pragma unroll
            for (int r = 0; r < 16; ++r) ps += p0[r];
#pragma unroll
            for (int r = 0; r < 16; ++r) ps += p1[r];
            { auto rr = __builtin_amdgcn_permlane32_swap(__float_as_uint(ps), __float_as_uint(ps), false, false); ps = __uint_as_float(rr[0]) + __uint_as_float(rr[1]); }
            l_reg = l_reg * alpha + ps;
            bf16x8 pa0, pa1, pa2, pa3;
#define PK4(P, BASE, OUT) do { unsigned a0 = cvtpk(P[BASE + 0], P[BASE + 1]), a1 = cvtpk(P[BASE + 2], P[BASE + 3]); \
            unsigned b0 = cvtpk(P[BASE + 4], P[BASE + 5]), b1 = cvtpk(P[BASE + 6], P[BASE + 7]); \
            auto r0 = __builtin_amdgcn_permlane32_swap(a0, b0, false, false); auto r1 = __builtin_amdgcn_permlane32_swap(a1, b1, false, false); \
            v4u w = {r0[0], r1[0], r0[1], r1[1]}; OUT = *reinterpret_cast<bf16x8*>(&w); } while (0)
            PK4(p0, 0, pa0); PK4(p0, 8, pa1); PK4(p1, 0, pa2); PK4(p1, 8, pa3);
#undef PK4
            const int vb = vb0 + buf * SHM_V;
            pv_one<0>(o[0], vb, pa0, pa1, pa2, pa3); if (VAR != 3) { pv_one<1>(o[1], vb, pa0, pa1, pa2, pa3); pv_one<2>(o[2], vb, pa0, pa1, pa2, pa3); pv_one<3>(o[3], vb, pa0, pa1, pa2, pa3); }
        }
    }
#undef SLOAD
#undef SWRITE
    if (hi == 0) li_l[r32] = l_reg;
    asm volatile("s_waitcnt lgkmcnt(0)" ::: "memory");
    int lane_o = lane; asm volatile("" : "+v"(lane_o));
    const int r32o = lane_o & 31, hio = lane_o >> 5;
    GAS unsigned char* xg = (GAS unsigned char*)XA; const GAS unsigned char* gg = (const GAS unsigned char*)GA;
    unsigned short gv[16][4];
#pragma unroll
    for (int r = 0; r < 16; ++r) { const int i = wid * 32 + crow(r, hio); const unsigned m = (unsigned)(m0 + (i < nrows_out ? i : 0)); const unsigned go = m * (unsigned)(NIN * 2) + (unsigned)r32o * 2u;
#pragma unroll
        for (int d0 = 0; d0 < 4; ++d0) gv[r][d0] = *(const GAS unsigned short*)(gg + go + d0 * 64); }
    __builtin_amdgcn_sched_barrier(0);
#pragma unroll
    for (int r = 0; r < 16; ++r) { const int orow = crow(r, hio), i = wid * 32 + orow; const float rl = __builtin_amdgcn_rcpf(li_l[orow]);
        if (i < nrows_out) { const unsigned m = (unsigned)(m0 + i); const unsigned xo = m * 8192u + (unsigned)r32o * 2u;
#pragma unroll
            for (int d0 = 0; d0 < 4; ++d0) { const float g = __uint_as_float(((unsigned)gv[r][d0]) << 16);
                const float val = o[d0][r] * rl * g; *(GAS unsigned short*)(xg + xo + d0 * 64) = (unsigned short)(cvtpk(val, val) & 0xffffu); } } }
    WG_BAR();
}
template <int VAR>
__device__ __forceinline__ void attn_phase(Frame& F, const float* qhg, bf16* xab_out) {
    const bf16* QRAW = (const bf16*)(F.ws + WS_QRAW); const float* TAB = (const float*)(F.ws + WS_TAB); const bf16* KA = (const bf16*)(F.ws + WS_KA); const bf16* VA = (const bf16*)(F.ws + WS_VA);
    bf16* XAB = xab_out; const bf16* PROJ = (const bf16*)(F.ws + WS_PROJ);
    LAS unsigned char* lds = F.lds + RING_OFF;
    const int wid = F.wave;
    const int npair = (512 - F.vcu + F.G - 1) / F.G, nmeta = F.vcu < 64 ? (64 - F.vcu + F.G - 1) / F.G : 0;
#pragma unroll 1
    for (int u = 0; u < 2 * npair + nmeta; ++u) {
        int bh, pos0, NT, lw, m0, nro;
        if (u < 2 * npair) { const int p = F.vcu + (u >> 1) * F.G, pi = p & 7, qb = (u & 1) ? pi : 15 - pi; bh = p >> 3;
            pos0 = N_META + 256 * qb; NT = 4 * qb + 5; lw = 4 * qb + 1 + (wid >> 1); m0 = (bh >> 4) * SEQ + 256 * qb; nro = 256; }
        else { bh = F.vcu + (u - 2 * npair) * F.G; pos0 = 0; NT = 1; lw = wid == 0 ? 0 : -1; m0 = MMAIN + (bh >> 4) * N_META; nro = 16; }
        const int h = bh & 15;
        attn_unit<VAR>(QRAW + h * QKD, qhg, TAB, pos0, KA + (size_t)bh * LP * QKD, VA + (size_t)bh * LP * VD, NT, lw, XAB + h * 128, PROJ + PC_GA + h * 128, m0, nro, lds);
    }
}
}

template <int NCT, int U, class Fn>
__device__ __forceinline__ void skinny_gemm(LAS unsigned char* lds, const bf16* A, int lda, const bf16* Bt, int ldb, int N, int K, int grp_cols, int a_grp_stride, int cu, int first_cu, int ncus, int G, const Fn& fn) {
    int tid = threadIdx.x; asm volatile("" : "+v"(tid));
    const int wave = __builtin_amdgcn_readfirstlane(tid >> 6), lane = tid & 63, fr = lane & 15, fq = lane >> 4;
    int rel = cu - first_cu; if (rel < 0) rel += G;
    if (rel >= ncus) return;
    const int nitems = N / (16 * NCT), ksl = K >> 3, k0 = wave * ksl;
    constexpr int PW = 64 * 16 * NCT;
#pragma unroll 1
    for (int item = rel; item < nitems; item += ncus) {
        const int n0 = item * 16 * NCT; const int acol = grp_cols ? (n0 / grp_cols) * a_grp_stride : 0;
        pg8::f32x4 acc[4][NCT];
#pragma unroll
        for (int rt = 0; rt < 4; ++rt)
#pragma unroll
            for (int ct = 0; ct < NCT; ++ct) acc[rt][ct] = (pg8::f32x4){0.f, 0.f, 0.f, 0.f};
        const GAS unsigned char* ap = (const GAS unsigned char*)(A + (size_t)fr * lda + acol + k0 + fq * 8);
        const GAS unsigned char* bp = (const GAS unsigned char*)(Bt + (size_t)(n0 + fr) * ldb + k0 + fq * 8);
        const unsigned astep = (unsigned)lda * 32u, bstep = (unsigned)ldb * 32u;
#pragma unroll 1
        for (int ks = 0; ks < ksl; ks += 32 * U) {
            bf16x8 a[U][4], b[U][NCT];
#pragma unroll
            for (int u = 0; u < U; ++u) {
#pragma unroll
                for (int rt = 0; rt < 4; ++rt) a[u][rt] = *(const GAS bf16x8*)(ap + rt * astep + (ks + 32 * u) * 2);
#pragma unroll
                for (int ct = 0; ct < NCT; ++ct) b[u][ct] = *(const GAS bf16x8*)(bp + ct * bstep + (ks + 32 * u) * 2); }
            __builtin_amdgcn_sched_barrier(0);
#pragma unroll
            for (int u = 0; u < U; ++u)
#pragma unroll
                for (int rt = 0; rt < 4; ++rt)
#pragma unroll
                    for (int ct = 0; ct < NCT; ++ct) acc[rt][ct] = __builtin_amdgcn_mfma_f32_16x16x32_bf16(b[u][ct], a[u][rt], acc[rt][ct], 0, 0, 0);
        }
        LAS float* P = (LAS float*)lds + wave * PW;
#pragma unroll
        for (int rt = 0; rt < 4; ++rt)
#pragma unroll
            for (int ct = 0; ct < NCT; ++ct) *(LAS pg8::f32x4*)(P + (rt * 16 + fr) * (16 * NCT) + ct * 16 + 4 * fq) = acc[rt][ct];
        WG_BAR();
        for (int c = tid; c < 64 * 4 * NCT; c += NWAVES * 64) { const int row = c / (4 * NCT), cc = (c - row * (4 * NCT)) * 4; const LAS float* p = (const LAS float*)lds + row * (16 * NCT) + cc;
            pg8::f32x4 vA = *(const LAS pg8::f32x4*)p, vB = *(const LAS pg8::f32x4*)(p + 4 * PW);
#pragma unroll
            for (int w = 1; w < 4; ++w) { vA += *(const LAS pg8::f32x4*)(p + w * PW); vB += *(const LAS pg8::f32x4*)(p + (4 + w) * PW); }
            fn(MMAIN + row, n0 + cc, vA, vB); }
        WG_BAR();
    }
}
__device__ __forceinline__ v2u pack4(const pg8::f32x4& v) { v2u w; w.x = cvtpk(v[0], v[1]); w.y = cvtpk(v[2], v[3]); return w; }
__device__ __forceinline__ float sigm(float x) { return __builtin_amdgcn_rcpf(1.0f + __builtin_amdgcn_exp2f(-1.4426950408889634f * x)); }
struct SkPlain { bf16* O; int ldc; const float* ss; float inv_n;
    __device__ __forceinline__ void operator()(int row, int col, pg8::f32x4 a, pg8::f32x4 b) const { *(GAS v2u*)(O + (size_t)row * ldc + col) = pack4((a + b) * (1.0f / sqrtf(ss[row] * inv_n + NORM_EPS))); } };
struct SkKV { bf16* KRAW; bf16* VA; const float* ss;
    __device__ __forceinline__ void operator()(int row, int col, pg8::f32x4 a, pg8::f32x4 b) const { const int h = col >> 8, c = col & 255; const v2u w = pack4((a + b) * (1.0f / sqrtf(ss[row] * (1.0f / 512.0f) + NORM_EPS)));
        if (c < 128) *(GAS v2u*)(KRAW + (size_t)row * 2048 + h * 128 + c) = w;
        else { const int j = row - MMAIN, bb = j >> 4, pp = j & 15; *(GAS v2u*)(VA + ((size_t)(bb * 16 + h) * LP + pp) * 128 + (c - 128)) = w; } } };
struct SkPool { bf16* XAB; const bf16* PROJ; const float* scale;
    __device__ __forceinline__ void operator()(int row, int col, pg8::f32x4 a, pg8::f32x4 b) const { const pg8::f32x4 sc = *(const GAS pg8::f32x4*)(scale + col); const v2u g = *(const GAS v2u*)(PROJ + (size_t)row * NIN + PC_GB + col);
        pg8::f32x4 v = (a + b) * sc; v[0] *= bflo(g.x); v[1] *= bfhi(g.x); v[2] *= bflo(g.y); v[3] *= bfhi(g.y); *(GAS v2u*)(XAB + (size_t)row * 4096 + 2048 + col) = pack4(v); } };
struct SkBranch { bf16* MG; const bf16* PROJ;
    __device__ __forceinline__ void operator()(int row, int col, pg8::f32x4 a, pg8::f32x4 b) const { const bf16* gp = PROJ + (size_t)row * NIN + PC_MA + (col >> 7) * 256 + (col & 127);
        const v2u gr = *(const GAS v2u*)gp, gb = *(const GAS v2u*)(gp + 128);
        pg8::f32x4 v; v[0] = (a[0] * bflo(gr.x) + b[0]) * bflo(gb.x); v[1] = (a[1] * bfhi(gr.x) + b[1]) * bfhi(gb.x); v[2] = (a[2] * bflo(gr.y) + b[2]) * bflo(gb.y); v[3] = (a[3] * bfhi(gr.y) + b[3]) * bfhi(gb.y);
        *(GAS v2u*)(MG + (size_t)row * 4096 + col) = pack4(v); } };
struct SkRes { bf16* HB; float* PART;
    __device__ __forceinline__ void operator()(int row, int col, pg8::f32x4 a, pg8::f32x4 b) const { const size_t off = (size_t)row * 4096 + col;
        const v2u r = *(const GAS v2u*)(HB + off); pg8::f32x4 h; h[0] = bflo(r.x); h[1] = bfhi(r.x); h[2] = bflo(r.y); h[3] = bfhi(r.y); h = h + a + b;
        *(GAS v2u*)(HB + off) = pack4(h);
        float ssum = (h[0] * h[0] + h[1] * h[1]) + (h[2] * h[2] + h[3] * h[3]); ssum += __shfl_xor(ssum, 1); ssum += __shfl_xor(ssum, 2);
        if ((col & 15) == 0) PART[(size_t)(row - MMAIN) * 256 + (col >> 4)] = ssum; } };
__device__ __forceinline__ void main_ss_reduce(Frame& F, const float* PARTM, float* SSN) {
    int tid = F.tid; asm volatile("" : "+v"(tid));
    for (int row = F.vcu * (NWAVES * 64) + tid; row < MMAIN; row += F.G * NWAVES * 64) { float a0 = 0.f, a1 = 0.f, a2 = 0.f, a3 = 0.f;
#pragma unroll
        for (int k = 0; k < 64; k += 4) { a0 += PARTM[(size_t)k * 16384 + row]; a1 += PARTM[(size_t)(k + 1) * 16384 + row]; a2 += PARTM[(size_t)(k + 2) * 16384 + row]; a3 += PARTM[(size_t)(k + 3) * 16384 + row]; }
        SSN[row] = (a0 + a1) + (a2 + a3); }
}
__device__ __forceinline__ void meta_ss_reduce(Frame& F, const float* PART, float* SSN) {
    const int gw = F.vcu * NWAVES + F.wave; int lane = F.lane; asm volatile("" : "+v"(lane));
    if (gw < NMETA_ROWS) { const pg8::f32x4 v = *((const GAS pg8::f32x4*)(PART + (size_t)gw * 256) + lane); const float t = wave_sum((v[0] + v[1]) + (v[2] + v[3])); if (lane == 0) SSN[MMAIN + gw] = t; }
}

__device__ __forceinline__ int opaque_reps(int n) { if (DBLMASK) asm volatile("" : "+s"(n)); return n; }
struct Args { const float* in[15]; float* out; unsigned char* ws; int ph_lo, ph_hi; };
constexpr int NPHASE = 1 + 7 * DEPTH;

__global__ void __launch_bounds__(NWAVES * 64, 2) trunk_fwd(Args args) {
    extern __shared__ __attribute__((aligned(16))) unsigned char lds_raw[];
    Frame F;
    F.lds = (LAS unsigned char*)lds_raw;
    F.tid = threadIdx.x; F.lane = F.tid & 63; F.wave = __builtin_amdgcn_readfirstlane(F.tid >> 6);
    F.G = gridDim.x; { const int bx = blockIdx.x; F.vcu = (F.G % 8 == 0) ? (bx % 8) * (F.G / 8) + bx / 8 : bx; }
    F.ws = args.ws; F.out = args.out;
#pragma unroll
    for (int i = 0; i < 15; ++i) F.in[i] = args.in[i];
    volatile LAS unsigned* MISC = (volatile LAS unsigned*)(F.lds + MISC_OFF);
    for (int u = F.tid; u < (LDS_BYTES - LDSCTL_OFF) / 4; u += NWAVES * 64) ((LAS unsigned*)(F.lds + LDSCTL_OFF))[u] = 0u;
    __syncthreads();
    unsigned* ctl = (unsigned*)(F.ws + WS_CTL);
    XcdBarrier bar; bar.bar = ctl + CW_BAR; bar.x = 0; bar.st = nullptr;
    if (!MK_PER_PHASE) bar = xcd_barrier_post(ctl + CW_BAR, MISC + 8);
    const int lo = args.ph_lo, hi = args.ph_hi; (void)lo; (void)hi;
#if MK_PER_PHASE
#define IN(k) (lo <= (k) && (k) < hi)
#else
#define IN(k) true
#endif
#ifndef PHMASK
#define PHMASK 0xFFFF
#endif
#define EN(b) ((PHMASK >> (b)) & 1)
#define DBL(b) ((DBLMASK >> (b)) & 1)
#define REPEAT(b) _Pragma("unroll 1") for (int rep_ = 0, nrep_ = opaque_reps(DBL(b) ? 2 : 1); rep_ < nrep_; ++rep_)
#define SEAM(k) do { if (!MK_PER_PHASE && IN((k) + 1)) { const int sk_ = (k); (void)sk_; BARW_BEGIN(); xcd_barrier(bar); BARW_END(); if (DBLMASK & 0x2000) xcd_barrier(bar); } TSTAMP(k); } while (0)
#ifdef TPROBE_SEL
#define TSTAMP(k) do { if (F.tid == 0) { const unsigned now_ = (unsigned)__builtin_amdgcn_s_memrealtime(); const int ty_ = (k) == 0 ? 0 : 1 + ((k) - 1) % 7; MISC[16 + ty_] += now_ - MISC[15]; MISC[15] = now_; } } while (0)
    if (F.tid == 0) MISC[15] = (unsigned)__builtin_amdgcn_s_memrealtime();
#define BARW_BEGIN() const unsigned bw0_ = (unsigned)__builtin_amdgcn_s_memrealtime(); do { int tt_ = F.tid; asm volatile("" : "+v"(tt_)); if (tt_ == 0) { atomicMax(ctl + CW_ARR + 2 * sk_, bw0_); atomicMax(ctl + CW_ARR + 2 * sk_ + 1, ~bw0_); } } while (0)
#ifdef SKEW_TYPE
#define BARW_END() do { } while (0)
#else
#define BARW_END() do { if (F.tid == 0) MISC[16 + 14] += (unsigned)__builtin_amdgcn_s_memrealtime() - bw0_; } while (0)
#endif
#define SKT_BEGIN() unsigned long long skt0_ = __builtin_amdgcn_s_memrealtime()
#define SKT_END() do { if (F.tid == 0) MISC[16 + 8] += (unsigned)(__builtin_amdgcn_s_memrealtime() - skt0_); } while (0)
#else
#define TSTAMP(k) do { } while (0)
#define BARW_BEGIN() do { } while (0)
#define BARW_END() do { } while (0)
#define SKT_BEGIN() do { } while (0)
#define SKT_END() do { } while (0)
#endif

    if (EN(0) && IN(0)) { REPEAT(0) { p0_prologue(F); VM_WAIT(); __syncthreads(); } SEAM(0); }

    for (int l = 0; l < DEPTH; ++l) {
        const int pb = 1 + 7 * l; const bool lastl = (l == DEPTH - 1);
        unsigned char* wl = F.ws + WS_W + (size_t)l * WL_SIZE;
        bf16* PROJ = (bf16*)(F.ws + WS_PROJ);
        const float* SSc = (const float*)(F.ws + WS_SS) + (size_t)(l & 1) * MPA; float* SSn = (float*)(F.ws + WS_SS) + (size_t)((l + 1) & 1) * MPA;
        if (EN(2) && IN(pb + 0)) {
            pg8::Gemm g{(const bf16*)(F.ws + WS_HN), (const bf16*)(wl + WL_IN), 4096, 4096, 4096}; pg8::StaticOrder S; S.init(MPA, NIN, F.G, (int)blockIdx.x);
            pg8::EpiProj E{PROJ, NIN, 14, 30, 30, 62, SSc, 1.0f / 4096.0f, (float*)(F.ws + WS_PARTQ), 6, MPA};
            REPEAT(2) pg8::gemm_phase<pg8::EpiProj, pg8::StaticOrder, PG8_ALIGN, PG8_SP2>(F.lds + RING_OFF, g, S, E);
            SEAM(pb + 0); }
        if (EN(3) && IN(pb + 1)) { REPEAT(3) p3_latent(F, F.in[I_QLG] + (size_t)l * 1024, F.in[I_KVLG] + (size_t)l * 512, lastl ? nullptr : SSn); SEAM(pb + 1); }
        if (IN(pb + 2)) {
            if (EN(4)) {
                pg8::Gemm g{PROJ + PC_CQ, (const bf16*)(wl + WL_UQ), NIN, 1024, 1024}; pg8::StaticOrder S; S.init(MMAIN, 3072, F.G, (int)blockIdx.x);
                pg8::EpiProj E{(bf16*)(F.ws + WS_QRAW), 3072, 0, 0, 0, 0, (const float*)(F.ws + WS_SSQ), 1.0f / 1024.0f, nullptr, 0, 0};
                REPEAT(4) pg8::gemm_phase<pg8::EpiProj, pg8::StaticOrder, PG8_ALIGN, PG8_SP2>(F.lds + RING_OFF, g, S, E);
                { SKT_BEGIN(); REPEAT(12) skinny_gemm<1, 4>(F.lds + RING_OFF, PROJ + (size_t)MMAIN * NIN + PC_CQ, NIN, (const bf16*)(wl + WL_UQ), 1024, 3072, 1024, 0, 0, (int)blockIdx.x, 0, F.G, F.G, SkPlain{(bf16*)(F.ws + WS_QRAW), 3072, (const float*)(F.ws + WS_SSQ), 1.0f / 1024.0f}); SKT_END(); } }
            if (EN(5)) {
                pg8::Gemm g{PROJ + PC_CKV, (const bf16*)(wl + WL_UKV), NIN, 512, 512}; pg8::StaticOrder S; S.init(MMAIN, 4096, F.G, (int)blockIdx.x);
                pg8::EpiKV E{(bf16*)(F.ws + WS_KRAW), (bf16*)(F.ws + WS_VA), LP, (const float*)(F.ws + WS_SSQ) + MPA};
                REPEAT(5) pg8::gemm_phase<pg8::EpiKV, pg8::StaticOrder, PG8_ALIGN, PG8_SP2>(F.lds + RING_OFF, g, S, E);
                { SKT_BEGIN(); REPEAT(12) skinny_gemm<1, 2>(F.lds + RING_OFF, PROJ + (size_t)MMAIN * NIN + PC_CKV, NIN, (const bf16*)(wl + WL_UKV), 512, 4096, 512, 0, 0, (int)blockIdx.x, 0, F.G, F.G, SkKV{(bf16*)(F.ws + WS_KRAW), (bf16*)(F.ws + WS_VA), (const float*)(F.ws + WS_SSQ) + MPA}); SKT_END(); } }
            if (EN(6)) {
                pg8::Gemm g{(const bf16*)(F.ws + WS_DIFF), (const bf16*)(wl + WL_POOL), 2048, 512, 512}; pg8::PoolOrder S; S.init(MMAIN, 2048, F.G, (int)blockIdx.x);
                pg8::EpiPool E{(bf16*)(F.ws + WS_XAB) + 2048, PROJ + PC_GB, NIN, F.in[I_PSCALE] + (size_t)l * 2048};
                REPEAT(6) pg8::gemm_phase<pg8::EpiPool, pg8::PoolOrder, PG8_ALIGN, PG8_SP2>(F.lds + RING_OFF, g, S, E);
                { SKT_BEGIN(); REPEAT(12) skinny_gemm<1, 2>(F.lds + RING_OFF, (const bf16*)(F.ws + WS_DIFF) + (size_t)MMAIN * 2048, 2048, (const bf16*)(wl + WL_POOL), 512, 2048, 512, 512, 512, (int)blockIdx.x, 0, F.G, F.G, SkPool{(bf16*)(F.ws + WS_XAB), PROJ, F.in[I_PSCALE] + (size_t)l * 2048}); SKT_END(); } }
            SEAM(pb + 2); }
        if (EN(7) && IN(pb + 3)) { REPEAT(7) p5_knorm(F, F.in[I_KHG] + (size_t)l * 192); SEAM(pb + 3); }
        if (EN(8) && IN(pb + 4)) { REPEAT(8) att::attn_phase<0>(F, F.in[I_QHG] + (size_t)l * 192, (bf16*)(F.ws + WS_XAB));
#ifdef ATT_PROBE_VAR
            att::attn_phase<ATT_PROBE_VAR>(F, F.in[I_QHG] + (size_t)l * 192, (bf16*)(F.ws + WS_T1));
#endif
            SEAM(pb + 4); }
        if (IN(pb + 5)) {
            if (EN(9)) {
                pg8::Gemm g{(const bf16*)(F.ws + WS_XAB), (const bf16*)(wl + WL_AB), 4096, 4096, 4096}; pg8::StaticOrder S; S.init(MMAIN, 4096, F.G, (int)blockIdx.x);
                pg8::EpiBranch E{(bf16*)(F.ws + WS_MG), PROJ + PC_MA, NIN};
                REPEAT(9) pg8::gemm_phase<pg8::EpiBranch, pg8::StaticOrder, PG8_ALIGN, PG8_SP2>(F.lds + RING_OFF, g, S, E);
                if (!lastl) { SKT_BEGIN(); REPEAT(12) skinny_gemm<1, 8>(F.lds + RING_OFF, (const bf16*)(F.ws + WS_XAB) + (size_t)MMAIN * 4096, 4096, (const bf16*)(wl + WL_AB), 4096, 4096, 4096, 0, 0, (int)blockIdx.x, 0, F.G, F.G, SkBranch{(bf16*)(F.ws + WS_MG), PROJ}); SKT_END(); } }
            SEAM(pb + 5); }
        if (EN(11) && IN(pb + 6)) {
            pg8::Gemm g{(const bf16*)(F.ws + WS_MG), (const bf16*)(wl + WL_OUT), 4096, 4096, 4096}; pg8::StaticOrder S; S.init(MMAIN, 4096, F.G, (int)blockIdx.x);
            pg8::EpiRes E{(bf16*)(F.ws + WS_HN), lastl ? F.out : nullptr, (float*)(F.ws + WS_PARTM)};
            pg8::gemm_phase<pg8::EpiRes, pg8::StaticOrder, PG8_ALIGN, PG8_SP2>(F.lds + RING_OFF, g, S, E);
            if (DBL(11) && lastl) { REPEAT(11) pg8::gemm_phase<pg8::EpiRes, pg8::StaticOrder, PG8_ALIGN, PG8_SP2>(F.lds + RING_OFF, g, S, E); }
            if (!lastl) { SKT_BEGIN(); skinny_gemm<1, 8>(F.lds + RING_OFF, (const bf16*)(F.ws + WS_MG) + (size_t)MMAIN * 4096, 4096, (const bf16*)(wl + WL_OUT), 4096, 4096, 4096, 0, 0, (int)blockIdx.x, 0, F.G, F.G, SkRes{(bf16*)(F.ws + WS_HN), (float*)(F.ws + WS_PART)}); SKT_END(); }
            if (!lastl && !MK_PER_PHASE) { xcd_barrier(bar); main_ss_reduce(F, (const float*)(F.ws + WS_PARTM), SSn); meta_ss_reduce(F, (const float*)(F.ws + WS_PART), SSn); }
            SEAM(pb + 6); }
    }
#ifdef TPROBE_SEL
    TSTAMP(NPHASE - 1);
#ifdef SKEW_TYPE
    if (F.tid == 0) { unsigned acc_ = 0; for (int k = 0; k < NPHASE - 1; ++k) { const int ty_ = k == 0 ? 0 : 1 + (k - 1) % 7; if (ty_ == SKEW_TYPE || SKEW_TYPE == 99) { const unsigned mx_ = xb_ld(ctl + CW_ARR + 2 * k), mn_ = ~xb_ld(ctl + CW_ARR + 2 * k + 1); acc_ += mx_ - mn_; } } MISC[16 + 15] = blockIdx.x == 0 ? acc_ : 0u; }
#endif
    __syncthreads();
    { const unsigned D = MISC[16 + TPROBE_SEL]; const unsigned long long t0 = __builtin_amdgcn_s_memrealtime(); while ((unsigned)(__builtin_amdgcn_s_memrealtime() - t0) < D) __builtin_amdgcn_s_sleep(20); }
#endif
#undef IN
#undef SEAM
}

extern "C" void kernel_launch(void* const* d_in, const int* in_sizes, int n_in, void* d_out, int out_size, void* d_ws, size_t ws_size, hipStream_t stream) {
    static int grid = 0;
    if (grid == 0) {
        if (n_in != 15 || out_size != BATCH * SEQ * D_MODEL || ws_size < WS_END) { fprintf(stderr, "kernel_launch: unexpected shapes (n_in %d out %d ws %zu need %zu)\n", n_in, out_size, ws_size, (size_t)WS_END); grid = -1; return; }
        int dev = 0, cus = 0, per_cu = 0;
        if (hipGetDevice(&dev) != hipSuccess || hipDeviceGetAttribute(&cus, hipDeviceAttributeMultiprocessorCount, dev) != hipSuccess) { grid = -1; return; }
        if (hipFuncSetAttribute((const void*)trunk_fwd, hipFuncAttributeMaxDynamicSharedMemorySize, LDS_BYTES) != hipSuccess) { fprintf(stderr, "kernel_launch: hipFuncSetAttribute failed\n"); grid = -1; return; }
        if (hipOccupancyMaxActiveBlocksPerMultiprocessor(&per_cu, (const void*)trunk_fwd, NWAVES * 64, LDS_BYTES) != hipSuccess || per_cu < 1) fprintf(stderr, "kernel_launch: occupancy query says %d\n", per_cu);
        (void)hipGetLastError();
        grid = cus;
    }
    if (grid < 0) return;
    if (hipMemsetAsync((char*)d_ws + WS_CTL, 0, (CW_ARR + 256) * 4, stream) != hipSuccess) return;
    Args a{};
    for (int i = 0; i < 15; ++i) a.in[i] = (const float*)d_in[i];
    a.out = (float*)d_out; a.ws = (unsigned char*)d_ws;
#if MK_PER_PHASE
    for (int p = 0; p < NPHASE; ++p) { a.ph_lo = p; a.ph_hi = p + 1; hipLaunchKernelGGL(trunk_fwd, dim3(grid), dim3(NWAVES * 64), LDS_BYTES, stream, a); }
#else
    a.ph_lo = 0; a.ph_hi = NPHASE; hipLaunchKernelGGL(trunk_fwd, dim3(grid), dim3(NWAVES * 64), LDS_BYTES, stream, a);
#endif
    (void)in_sizes;
}
```
